# Optimizing an MI355X kernel written in HIP

```python
import math
import jax, jax.numpy as jnp
from jax import lax
import numpy as np

D_MODEL = 1024
BATCH = 8
SEQ = 2048
DEPTH = 2
DEC_BATCH = 8
DEC_SEQ = 8192
PAST_LEN = 128

HEAD_DIM = 64
A_HEADS = 8
A_PATTERNS = ((128, 1), (512, 4), (2048, 16))
B_HEADS = 8
B_KV_HEADS = 2
Q_BLOCK = 128
GRID_W = 64
ROPE_THETA = 500000.0
ROPE_DIM = HEAD_DIM // 4
AXIAL_THETA = 10000.0
C_HEADS = 8
C_KEY = 128
C_VAL = 128
C_CHUNK = 64
D_FF = 2816
CONV_W = 3
ALPHA = (2 * DEPTH) ** 0.25
BETA = (8 * DEPTH) ** -0.25
LN_EPS = 1e-5
RMS_EPS = 1e-6
N_AB = (DEPTH + 1) // 2
N_C = DEPTH // 2
A_W = A_HEADS * HEAD_DIM
B_QW = B_HEADS * HEAD_DIM
B_KVW = B_KV_HEADS * HEAD_DIM
AB_IN = 3 * A_W + B_QW + 2 * B_KVW
AB_OUT = A_W + B_QW
C_W = C_HEADS * C_KEY
C_VW = C_HEADS * C_VAL
C_IN = 3 * C_W + 2 * C_VW

kernel_name = "hybrid_dilated_gqa_hgrn2_encoder"


def _layer_norm(x, g, b):
    xf = x.astype(jnp.float32)
    mu = jnp.mean(xf, -1, keepdims=True)
    var = jnp.mean(jnp.square(xf - mu), -1, keepdims=True)
    return ((xf - mu) * lax.rsqrt(var + LN_EPS) * g + b).astype(x.dtype)


def _rms_norm(x, g):
    xf = x.astype(jnp.float32)
    return (xf * lax.rsqrt(jnp.mean(xf * xf, -1, keepdims=True) + RMS_EPS) * g).astype(x.dtype)


def _rope_angles(pos, dim, theta):
    freqs = theta ** (-(jnp.arange(0, dim, 2, dtype=jnp.float32) / dim))
    ang = pos.astype(jnp.float32)[:, None] * freqs[None, :]
    return jnp.cos(ang), jnp.sin(ang)


def _apply_rope(x, cos, sin):
    half = x.shape[-1] // 2
    xf = x.astype(jnp.float32)
    x1, x2 = xf[..., :half], xf[..., half:]
    c = cos[None, :, None, :]
    s = sin[None, :, None, :]
    return jnp.concatenate([x1 * c - x2 * s, x2 * c + x1 * s], -1).astype(x.dtype)


def _dilated_branch(q, k, v, dil, n):
    B, S, H, D = q.shape
    m = S // dil
    L = n
    nb = -(-m // L)
    M = nb * L
    Bp = B * dil

    def to_cls(t):
        return t.reshape(B, m, dil, H, D).transpose(0, 2, 1, 3, 4).reshape(Bp, m, H, D)

    qc = jnp.pad(to_cls(q), ((0, 0), (0, M - m), (0, 0), (0, 0))).reshape(Bp, nb, L, H, D)

    def band(t):
        tp = jnp.pad(to_cls(t), ((0, 0), (L, M - m + L), (0, 0), (0, 0))).reshape(Bp, nb + 2, L, H, D)
        return jnp.concatenate([tp[:, :-2], tp[:, 1:-1], tp[:, 2:]], axis=2)

    kb, vb = band(k), band(v)
    s = jnp.einsum('bnqhd,bnkhd->bnhqk', qc, kb).astype(jnp.float32) * (D ** -0.5)
    qi = jnp.arange(nb)[:, None] * L + jnp.arange(L)[None, :]
    ki = jnp.arange(nb)[:, None] * L - L + jnp.arange(3 * L)[None, :]
    rel = ki[:, None, :] - qi[:, :, None]
    valid = ((jnp.abs(rel) <= n) & (ki[:, None, :] >= 0) & (ki[:, None, :] < m)) | (rel == 0)
    s = jnp.where(valid[None, :, None], s, -jnp.inf)
    lse = jax.nn.logsumexp(s, axis=-1)
    p = jnp.exp(s - lse[..., None]).astype(v.dtype)
    o = jnp.einsum('bnhqk,bnkhd->bnqhd', p, vb).reshape(Bp, M, H, D)[:, :m]
    lse = lse.transpose(0, 1, 3, 2).reshape(Bp, M, H)[:, :m]
    o = o.reshape(B, dil, m, H, D).transpose(0, 2, 1, 3, 4).reshape(B, S, H, D)
    lse = lse.reshape(B, dil, m, H).transpose(0, 2, 1, 3).reshape(B, S, H)
    return o, lse


def _dilated_attention(q, k, v):
    outs, lses = [], []
    for window, dil in A_PATTERNS:
        o, l = _dilated_branch(q, k, v, dil, window // (2 * dil))
        outs.append(o)
        lses.append(l)
    w = jax.nn.softmax(jnp.stack(lses, 0), axis=0).astype(q.dtype)
    return jnp.einsum('gbsh,gbshd->bshd', w, jnp.stack(outs, 0))


def _gqa_blocks(q, k, v):
    B, S, Hq, D = q.shape
    Hkv = k.shape[2]
    G = Hq // Hkv
    nqb = S // Q_BLOCK
    qb = q.reshape(B, nqb, Q_BLOCK, Hkv, G, D).transpose(1, 0, 2, 3, 4, 5)

    def one_block(qblk):
        s = jnp.einsum('bqkgd,bskd->bkgqs', qblk, k).astype(jnp.float32) * (D ** -0.5)
        p = jax.nn.softmax(s, axis=-1).astype(v.dtype)
        return jnp.einsum('bkgqs,bskd->bqkgd', p, v)

    o = lax.map(one_block, qb)
    return o.transpose(1, 0, 2, 3, 4, 5).reshape(B, S, Hq * D)


def _mixer_ab(x, w_in, w_out, qn, kn):
    B, S, _ = x.shape
    h = x @ w_in
    o1, o2, o3 = A_W, 2 * A_W, 3 * A_W
    o4 = o3 + B_QW
    o5 = o4 + B_KVW
    qa = h[..., :o1].reshape(B, S, A_HEADS, HEAD_DIM)
    ka = h[..., o1:o2].reshape(B, S, A_HEADS, HEAD_DIM)
    va = h[..., o2:o3].reshape(B, S, A_HEADS, HEAD_DIM)
    qb = h[..., o3:o4].reshape(B, S, B_HEADS, HEAD_DIM)
    kb = h[..., o4:o5].reshape(B, S, B_KV_HEADS, HEAD_DIM)
    vb = h[..., o5:].reshape(B, S, B_KV_HEADS, HEAD_DIM)

    cos, sin = _rope_angles(jnp.arange(S), ROPE_DIM, ROPE_THETA)

    def prope(t):
        return jnp.concatenate([_apply_rope(t[..., :ROPE_DIM], cos, sin), t[..., ROPE_DIM:]], -1)

    ya = _dilated_attention(prope(qa), prope(ka), va).reshape(B, S, A_W)

    rows = S // GRID_W
    row = jnp.broadcast_to(jnp.arange(rows)[:, None], (rows, GRID_W)).reshape(S)
    col = jnp.broadcast_to(jnp.arange(GRID_W)[None, :], (rows, GRID_W)).reshape(S)
    half = HEAD_DIM // 2
    cr, sr = _rope_angles(row, half, AXIAL_THETA)
    cc, sc = _rope_angles(col, half, AXIAL_THETA)

    def arope(t):
        return jnp.concatenate([_apply_rope(t[..., :half], cr, sr), _apply_rope(t[..., half:], cc, sc)], -1)

    qb = arope(_rms_norm(qb, qn))
    kb = arope(_rms_norm(kb, kn))
    yb = _gqa_blocks(qb, kb, vb)
    return jnp.concatenate([ya, yb], -1) @ w_out


def _hgrn2_scan(q, k, v, logf):
    B, S, H, K = q.shape
    V = v.shape[-1]
    nc = S // C_CHUNK

    def chunks(t):
        return t.reshape(B, nc, C_CHUNK, H, t.shape[-1]).swapaxes(0, 1)

    lower = jnp.tril(jnp.ones((C_CHUNK, C_CHUNK), dtype=bool))[None, :, :, None, None]

    def step(state, inp):
        qc, kc, vc, gc = inp
        b = jnp.cumsum(gc, axis=1)
        o_inter = jnp.einsum('bthk,bhkv->bthv', qc * jnp.exp(b), state)
        dec = jnp.where(lower, jnp.exp(jnp.minimum(b[:, :, None] - b[:, None, :], 0.0)), 0.0)
        attn = jnp.einsum('bthk,btshk,bshk->bths', qc, dec, kc)
        o_intra = jnp.einsum('bths,bshv->bthv', attn, vc)
        b_last = b[:, -1]
        state = jnp.exp(b_last)[..., None] * state + jnp.einsum(
            'bshk,bshv->bhkv', kc * jnp.exp(b_last[:, None] - b), vc)
        return state, o_inter + o_intra

    s0 = jnp.zeros((B, H, K, V), jnp.float32)
    _, o = lax.scan(step, s0, (chunks(q), chunks(k), chunks(v), chunks(logf)))
    return o.swapaxes(0, 1).reshape(B, S, H, V)


def _mixer_hgrn2(x, w_in, w_out, lb_fwd, lb_bwd, gn, layer):
    B, S, _ = x.shape
    h = x @ w_in
    q = h[..., :C_W].reshape(B, S, C_HEADS, C_KEY).astype(jnp.float32)
    zf = h[..., C_W:2 * C_W].reshape(B, S, C_HEADS, C_KEY).astype(jnp.float32)
    zb = h[..., 2 * C_W:3 * C_W].reshape(B, S, C_HEADS, C_KEY).astype(jnp.float32)
    i = h[..., 3 * C_W:3 * C_W + C_VW].reshape(B, S, C_HEADS, C_VAL).astype(jnp.float32)
    g = h[..., 3 * C_W + C_VW:]

    def lower_bound(tbl):
        p = jax.nn.softmax(tbl.astype(jnp.float32), axis=0)
        return (jnp.cumsum(p, axis=0) - p[0])[layer].reshape(C_HEADS, C_KEY)

    def gates(z, lb):
        f = lb + (1.0 - lb) * jax.nn.sigmoid(z)
        return jnp.log(f), 1.0 - f

    v = jax.nn.silu(i)
    logf_f, k_f = gates(zf, lower_bound(lb_fwd))
    logf_b, k_b = gates(zb, lower_bound(lb_bwd))
    o_f = _hgrn2_scan(q, k_f, v, logf_f)
    flip = lambda t: jnp.flip(t, axis=1)
    o_b = flip(_hgrn2_scan(flip(q), flip(k_b), flip(v), flip(logf_b)))
    o = _rms_norm(o_f + o_b, gn.reshape(C_HEADS, C_VAL)).astype(x.dtype)
    o = o.reshape(B, S, C_VW) * jax.nn.silu(g)
    return o @ w_out


def _conv_ffn(x, w_up, conv_w, conv_b, w_down):
    h = x @ w_up
    u, g = h[..., :D_FF], h[..., D_FF:]
    gp = jnp.pad(g, ((0, 0), (1, 1), (0, 0)))
    g = gp[:, :-2] * conv_w[0] + gp[:, 1:-1] * conv_w[1] + gp[:, 2:] * conv_w[2] + conv_b
    return (jax.nn.gelu(g) * u) @ w_down


def _trunk(x, w_in_ab, w_out_ab, qn_ab, kn_ab, w_in_c, w_out_c, lb_fwd, lb_bwd, gn_c,
           ln_mix_g, ln_mix_b, ln_ffn_g, ln_ffn_b, ffn_w_up, ffn_conv_w, ffn_conv_b, ffn_w_down):
    for l in range(DEPTH):
        j = l // 2
        if l % 2 == 0:
            y = _mixer_ab(x, w_in_ab[j], w_out_ab[j], qn_ab[j], kn_ab[j])
        else:
            y = _mixer_hgrn2(x, w_in_c[j], w_out_c[j], lb_fwd, lb_bwd, gn_c[j], l)
        x = _layer_norm(ALPHA * x + y, ln_mix_g[l], ln_mix_b[l])
        y = _conv_ffn(x, ffn_w_up[l], ffn_conv_w[l], ffn_conv_b[l], ffn_w_down[l])
        x = _layer_norm(ALPHA * x + y, ln_ffn_g[l], ln_ffn_b[l])
    return x


def setup_inputs(seed: int = 0) -> dict:
    key = jax.random.key(seed)
    ks = jax.random.split(key, 24)

    def nrm(k, shape, scale):
        return jax.random.normal(k, shape, jnp.float32) * scale

    ab_cols = jnp.ones((AB_IN,), jnp.float32).at[2 * A_W:3 * A_W].set(BETA).at[3 * A_W + B_QW + B_KVW:].set(BETA)
    c_cols = jnp.ones((C_IN,), jnp.float32).at[3 * C_W:3 * C_W + C_VW].set(BETA)
    return {
        "x_prompt": nrm(ks[0], (BATCH, SEQ, D_MODEL), 1.0),
        "x_sample": nrm(ks[1], (DEC_BATCH, DEC_SEQ, D_MODEL), 1.0),
        "w_in_ab": nrm(ks[2], (N_AB, D_MODEL, AB_IN), D_MODEL ** -0.5) * ab_cols,
        "w_out_ab": nrm(ks[3], (N_AB, AB_OUT, D_MODEL), BETA * AB_OUT ** -0.5),
        "qn_ab": 1.0 + nrm(ks[4], (N_AB, HEAD_DIM), 0.01),
        "kn_ab": 1.0 + nrm(ks[5], (N_AB, HEAD_DIM), 0.01),
        "w_in_c": nrm(ks[6], (N_C, D_MODEL, C_IN), D_MODEL ** -0.5) * c_cols,
        "w_out_c": nrm(ks[7], (N_C, C_VW, D_MODEL), BETA * C_VW ** -0.5),
        "lb_fwd": nrm(ks[8], (DEPTH, C_W), 0.1),
        "lb_bwd": nrm(ks[9], (DEPTH, C_W), 0.1),
        "gn_c": 1.0 + nrm(ks[10], (N_C, C_VW), 0.01),
        "ln_mix_g": 1.0 + nrm(ks[11], (DEPTH, D_MODEL), 0.01),
        "ln_mix_b": nrm(ks[12], (DEPTH, D_MODEL), 0.01),
        "ln_ffn_g": 1.0 + nrm(ks[13], (DEPTH, D_MODEL), 0.01),
        "ln_ffn_b": nrm(ks[14], (DEPTH, D_MODEL), 0.01),
        "ffn_w_up": nrm(ks[15], (DEPTH, D_MODEL, 2 * D_FF), D_MODEL ** -0.5),
        "ffn_conv_w": nrm(ks[16], (DEPTH, CONV_W, D_FF), CONV_W ** -0.5),
        "ffn_conv_b": nrm(ks[17], (DEPTH, D_FF), 0.01),
        "ffn_w_down": nrm(ks[18], (DEPTH, D_FF, D_MODEL), BETA * D_FF ** -0.5),
    }


def reference(x_prompt, x_sample, w_in_ab, w_out_ab, qn_ab, kn_ab, w_in_c, w_out_c, lb_fwd, lb_bwd,
              gn_c, ln_mix_g, ln_mix_b, ln_ffn_g, ln_ffn_b, ffn_w_up, ffn_conv_w, ffn_conv_b, ffn_w_down):
    y_prompt = _trunk(x_prompt, w_in_ab, w_out_ab, qn_ab, kn_ab, w_in_c, w_out_c, lb_fwd, lb_bwd, gn_c,
                      ln_mix_g, ln_mix_b, ln_ffn_g, ln_ffn_b, ffn_w_up, ffn_conv_w, ffn_conv_b, ffn_w_down)
    y_sample = _trunk(x_sample, w_in_ab, w_out_ab, qn_ab, kn_ab, w_in_c, w_out_c, lb_fwd, lb_bwd, gn_c,
                      ln_mix_g, ln_mix_b, ln_ffn_g, ln_ffn_b, ffn_w_up, ffn_conv_w, ffn_conv_b, ffn_w_down)
    return (y_prompt, y_sample)
```

```cpp
#include <hip/hip_runtime.h>
#include <hip/hip_cooperative_groups.h>
#include <cstdio>
#include <cstdint>
namespace pg8 {
#define PG8_LAS __attribute__((address_space(3)))
typedef unsigned short bf16_t;
typedef short bf16x8 __attribute__((ext_vector_type(8)));
typedef float f32x4 __attribute__((ext_vector_type(4)));
typedef unsigned u32x4 __attribute__((ext_vector_type(4)));
constexpr int BM = 256, BK = 64, HALF = 128, HTB = HALF * BK * 2  , STAGE_BYTES = 8 * HTB, NXCD = 8, WGM = 8;

__host__ __device__ __forceinline__ int lds_byte(int r, int c) { const int st = (r >> 4) * 2 + (c >> 5), rr = r & 15, cc = c & 31, ob = rr * 64 + cc * 2; return st * 1024 + (ob ^ (((ob >> 9) & 1) << 5)); }
__host__ __device__ __forceinline__ void stage_rc(int b, int& R, int& C) { const int st = b / 1024, sb = b % 1024, swz = sb ^ (((sb >> 9) & 1) << 5); R = (st >> 1) * 16 + swz / 64; C = (st & 1) * 32 + (swz % 64) / 2; }
__host__ __device__ __forceinline__ int perm32(int rho) { const int n = rho >> 4, i = rho & 15; return 8 * (i >> 2) + 4 * n + (i & 3); }

struct Unit { int pm, pn; };
struct Gemm { const bf16_t* A; const bf16_t* Bt; int M, N, K; };

struct StaticOrder {
    int nM, nN, nwg, G, c;
    __host__ __device__ void init(int M, int N, int G_, int c_) { nM = M / BM; nN = N / BM; nwg = nM * nN; G = G_; c = c_; }
    __host__ __device__ bool next(int i, Unit& u) const {
        const long L = (long)i * G + c; if (L >= nwg) return false;
        int wgid = (int)L; { const int q = nwg / NXCD, r = nwg % NXCD, xcd = wgid % NXCD, off = wgid / NXCD; wgid = (xcd < r ? xcd * (q + 1) : r * (q + 1) + (xcd - r) * q) + off; }
        const int nig = WGM * nN, gid = wgid / nig, fm = gid * WGM, gsz = (nM - fm) < WGM ? (nM - fm) : WGM;
        u.pm = fm + ((wgid % nig) % gsz); u.pn = (wgid % nig) / gsz; return true;
    }
    __device__ __forceinline__ void a_ready(const Unit&) const {}
    __device__ __forceinline__ void done(const Unit&) const {}
};

__device__ __forceinline__ unsigned cvt_pk_bf16(float lo, float hi) { unsigned r; asm volatile("v_cvt_pk_bf16_f32 %0, %1, %2" : "=v"(r) : "v"(lo), "v"(hi)); return r; }
typedef float f32x2 __attribute__((ext_vector_type(2)));
__device__ __forceinline__ f32x2 gelu_pk(f32x2 v) {
    const f32x2 av = __builtin_elementwise_abs(v), d = av * 0.2316418882f + 1.0f;
    f32x2 t; t.x = __builtin_amdgcn_rcpf(d.x); t.y = __builtin_amdgcn_rcpf(d.y);
    f32x2 q = t * 0.5307027145f + (-0.7265760135f); q = q * t + 0.7107068705f; q = q * t + (-0.142248368f); q = q * t + 0.127414796f; q = q * t;
    const f32x2 s = (v * v) * (-0.72134752044f);
    f32x2 e; e.x = __builtin_amdgcn_exp2f(s.x); e.y = __builtin_amdgcn_exp2f(s.y);
    const f32x2 m = v * (q * e), r = v - m;
    f32x2 o; o.x = v.x < 0.f ? m.x : r.x; o.y = v.y < 0.f ? m.y : r.y; return o;
}

template <int ACT  > struct EpiBf16 {
    static constexpr bool PERM = true, AFTER_DRAIN = false; static_assert(ACT == 0 || ACT == 1, "EpiBf16: ACT is 0 (none) or 1 (gelu_pk)");
    bf16_t* O; int ldc; const float* bias; int split_cols; size_t split_stride; float scale0;
    __device__ __forceinline__ void operator()(const f32x4 (&acc)[2][2][4][2], const Unit& u, int wr, int wc, int fr, int fq) const {
        const int row0 = u.pm * BM + wr * 64 + fr; int colt = u.pn * BM; bf16_t* base = O;
        float sc = 1.f; if (split_cols) { const int t = colt / split_cols; base += (size_t)t * split_stride; colt -= t * split_cols; if (t == 0) sc = scale0; }
        const int col0 = colt + wc * 32 + 8 * fq, bcol0 = u.pn * BM + wc * 32 + 8 * fq;
        f32x4 bv[2][2];
#pragma unroll
        for (int bj = 0; bj < 2; ++bj)
#pragma unroll
            for (int n = 0; n < 2; ++n) bv[bj][n] = bias ? *(const f32x4*)(bias + bcol0 + bj * HALF + 4 * n) : (f32x4){0.f, 0.f, 0.f, 0.f};
#pragma unroll
        for (int ai = 0; ai < 2; ++ai)
#pragma unroll
            for (int m = 0; m < 4; ++m) { bf16_t* rowp = base + (size_t)(row0 + ai * HALF + m * 16) * ldc + col0;
#pragma unroll
                for (int bj = 0; bj < 2; ++bj) { f32x4 v0 = acc[ai][bj][m][0] + bv[bj][0], v1 = acc[ai][bj][m][1] + bv[bj][1];
                    if (ACT == 1) { f32x2 a = gelu_pk((f32x2){v0[0], v0[1]}), b = gelu_pk((f32x2){v0[2], v0[3]}), c = gelu_pk((f32x2){v1[0], v1[1]}), d = gelu_pk((f32x2){v1[2], v1[3]});
                        v0 = (f32x4){a.x, a.y, b.x, b.y}; v1 = (f32x4){c.x, c.y, d.x, d.y}; }
                    v0 = v0 * sc; v1 = v1 * sc; u32x4 w; w.x = cvt_pk_bf16(v0[0], v0[1]); w.y = cvt_pk_bf16(v0[2], v0[3]); w.z = cvt_pk_bf16(v1[0], v1[1]); w.w = cvt_pk_bf16(v1[2], v1[3]);
                    *(u32x4*)(rowp + bj * HALF) = w; } }
    }
};

struct PanelStats {
    unsigned* xbuf;
    unsigned* cnt;
    unsigned* tmo;
    int ntn; float eps;
    unsigned code;
    __device__ __forceinline__ bool run(const f32x4 (&v)[2][2][4][2], const Unit& u, int wr, int wc, int fr, int fq, PG8_LAS unsigned char* lds, int wid, int lane) const {
        typedef float f32x2v __attribute__((ext_vector_type(2)));
        PG8_LAS f32x2v* P = (PG8_LAS f32x2v*)lds;
        PG8_LAS f32x2v* S = (PG8_LAS f32x2v*)(lds + 8192);
        PG8_LAS unsigned* flag = (PG8_LAS unsigned*)(lds + 8192 + 2048);
#pragma unroll
        for (int ai = 0; ai < 2; ++ai)
#pragma unroll
            for (int m = 0; m < 4; ++m) {
                float s = 0.f;
#pragma unroll
                for (int bj = 0; bj < 2; ++bj)
#pragma unroll
                    for (int n = 0; n < 2; ++n) { const f32x4 x = v[ai][bj][m][n]; s += (x[0] + x[1]) + (x[2] + x[3]); }
                s += __shfl_xor(s, 16); s += __shfl_xor(s, 32);
                const float mw = s * (1.0f / 64.0f); float q = 0.f;
#pragma unroll
                for (int bj = 0; bj < 2; ++bj)
#pragma unroll
                    for (int n = 0; n < 2; ++n) { const f32x4 d = v[ai][bj][m][n] - mw; q += (d[0] * d[0] + d[1] * d[1]) + (d[2] * d[2] + d[3] * d[3]); }
                q += __shfl_xor(q, 16); q += __shfl_xor(q, 32);
                if (fq == 0) P[(ai * HALF + wr * 64 + m * 16 + fr) * 4 + wc] = (f32x2v){mw, q};
            }
        asm volatile("s_waitcnt lgkmcnt(0)" ::: "memory"); __builtin_amdgcn_s_barrier(); asm volatile("" ::: "memory");
#if defined(BROKEN_EXCHANGE_NO_WAIT)
#warning BROKEN CONTROL BUILD: the row-statistics exchange does not wait; results are wrong by design
        if (blockIdx.x >= 64) { const long long t0_ = clock64(); while (clock64() - t0_ < 60000) __builtin_amdgcn_s_sleep(8); }
#endif
        const int row = wid * 32 + (lane & 31);
        if (lane < 32) {
            const f32x2v a = P[row * 4 + 0], b = P[row * 4 + 1], c = P[row * 4 + 2], d = P[row * 4 + 3];
            const float mt = (a.x + b.x + c.x + d.x) * 0.25f;
            const float da = a.x - mt, db = b.x - mt, dc = c.x - mt, dd = d.x - mt;
            const float m2 = (a.y + b.y) + (c.y + d.y) + 64.0f * ((da * da + db * db) + (dc * dc + dd * dd));
            unsigned long long* slot = (unsigned long long*)xbuf + ((size_t)(u.pm * BM + row) * 4 + u.pn);
            __hip_atomic_store(slot, ((unsigned long long)__float_as_uint(m2) << 32) | __float_as_uint(mt), __ATOMIC_RELAXED, __HIP_MEMORY_SCOPE_AGENT);
        }
        asm volatile("s_waitcnt vmcnt(0)" ::: "memory");
        if (lane == 0) __hip_atomic_fetch_add(cnt + 64 * u.pm, 1u, __ATOMIC_RELAXED, __HIP_MEMORY_SCOPE_AGENT);
        if (wid == 0) {
            bool dead = false; const unsigned long long t0 = __builtin_amdgcn_s_memrealtime(); const unsigned want = 8u * (unsigned)ntn;
            for (;;) {
#if defined(BROKEN_EXCHANGE_NO_WAIT)
                break;
#endif
                if ((unsigned)__builtin_amdgcn_readfirstlane(__hip_atomic_load(cnt + 64 * u.pm, __ATOMIC_RELAXED, __HIP_MEMORY_SCOPE_AGENT)) >= want) break;
                if (__builtin_amdgcn_s_memrealtime() - t0 > 2000000ull) {
                    if (lane == 0) { unsigned expect = 0u; __hip_atomic_compare_exchange_strong(tmo + 1, &expect, code | (unsigned)(u.pm & 0xff), __ATOMIC_RELAXED, __ATOMIC_RELAXED, __HIP_MEMORY_SCOPE_AGENT);
                                     __hip_atomic_store(tmo, 1u, __ATOMIC_RELAXED, __HIP_MEMORY_SCOPE_AGENT); }
                    dead = true; break; }
                __builtin_amdgcn_s_sleep(2);
            }
            __builtin_amdgcn_fence(__ATOMIC_ACQUIRE, "agent");
            if (lane == 0) flag[0] = dead ? 1u : 0u;
        }
        asm volatile("s_waitcnt vmcnt(0) lgkmcnt(0)" ::: "memory"); __builtin_amdgcn_s_barrier(); asm volatile("" ::: "memory");
        const bool bad = flag[0] != 0u;
        if (lane < 32) {
            const unsigned long long* slot = (const unsigned long long*)xbuf + (size_t)(u.pm * BM + row) * 4; float mt[4], m2[4]; float ms = 0.f;
#pragma unroll
            for (int t = 0; t < 4; ++t) { if (t < ntn) { const unsigned long long w = __hip_atomic_load(slot + t, __ATOMIC_RELAXED, __HIP_MEMORY_SCOPE_AGENT); mt[t] = __uint_as_float((unsigned)w); m2[t] = __uint_as_float((unsigned)(w >> 32)); } else { mt[t] = 0.f; m2[t] = 0.f; } ms += mt[t]; }
            const float mean = ms / (float)ntn; float q = 0.f;
#pragma unroll
            for (int t = 0; t < 4; ++t) if (t < ntn) { const float dm = mt[t] - mean; q += m2[t] + 256.0f * dm * dm; }
            S[row] = (f32x2v){mean, 1.0f / sqrtf(q / (256.0f * (float)ntn) + eps)};
        }
        asm volatile("s_waitcnt lgkmcnt(0)" ::: "memory"); __builtin_amdgcn_s_barrier(); asm volatile("" ::: "memory");
        return bad;
    }
};
struct EpiLnRes {
    static constexpr bool PERM = false, AFTER_DRAIN = true;
    const float* base; float* out; int ldc; const float* bias; PanelStats st; unsigned poison;
    __device__ __forceinline__ void fused(f32x4 (&acc)[2][2][4][2], const Unit& u, int wr, int wc, int fr, int fq, PG8_LAS unsigned char* lds, int wid, int lane) const {
        typedef float f32x2v __attribute__((ext_vector_type(2)));
        const PG8_LAS f32x2v* S = (const PG8_LAS f32x2v*)(lds + 8192);
        const int col0 = u.pn * BM + wc * 32 + 4 * fq;
#pragma unroll
        for (int bj = 0; bj < 2; ++bj)
#pragma unroll
            for (int n = 0; n < 2; ++n) { const f32x4 bv = bias ? *(const f32x4*)(bias + col0 + bj * HALF + n * 16) : (f32x4){0.f, 0.f, 0.f, 0.f};
#pragma unroll
                for (int ai = 0; ai < 2; ++ai)
#pragma unroll
                    for (int m = 0; m < 4; ++m) acc[ai][bj][m][n] += bv; }
        f32x4 pre[4][2][2];
#pragma unroll
        for (int m = 0; m < 4; ++m) { const size_t off = (size_t)(u.pm * BM + wr * 64 + m * 16 + fr) * ldc + col0;
#pragma unroll
            for (int bj = 0; bj < 2; ++bj)
#pragma unroll
                for (int n = 0; n < 2; ++n) pre[m][bj][n] = *(const f32x4*)(base + off + bj * HALF + n * 16); }
        const bool bad = st.run(acc, u, wr, wc, fr, fq, lds, wid, lane) || poison != 0u;
        const float qnan = __builtin_nanf("");
#pragma unroll
        for (int ai = 0; ai < 2; ++ai)
#pragma unroll
            for (int m = 0; m < 4; ++m) { const int r = ai * HALF + wr * 64 + m * 16 + fr; const f32x2v sr = S[r]; const size_t off = (size_t)(u.pm * BM + r) * ldc + col0;
#pragma unroll
                for (int bj = 0; bj < 2; ++bj)
#pragma unroll
                    for (int n = 0; n < 2; ++n) { const f32x4 bs = ai == 0 ? pre[m][bj][n] : *(const f32x4*)(base + off + bj * HALF + n * 16); f32x4 o = bs + (acc[ai][bj][m][n] - sr.x) * sr.y;
                        if (bad) o = (f32x4){qnan, qnan, qnan, qnan}; *(f32x4*)(out + off + bj * HALF + n * 16) = o; }
                if (m & 1) asm volatile("" ::: "memory"); }
    }
};
struct EpiLnResLn {
    static constexpr bool PERM = false, AFTER_DRAIN = true;
    const float* base; float* out; bf16_t* xn; int ldc; const float* bias; PanelStats st1, st2; unsigned poison;
    __device__ __forceinline__ void fused(f32x4 (&acc)[2][2][4][2], const Unit& u, int wr, int wc, int fr, int fq, PG8_LAS unsigned char* lds, int wid, int lane) const {
        typedef float f32x2v __attribute__((ext_vector_type(2))); typedef unsigned u32x2v __attribute__((ext_vector_type(2)));
        const PG8_LAS f32x2v* S = (const PG8_LAS f32x2v*)(lds + 8192);
        const int col0 = u.pn * BM + wc * 32 + 4 * fq;
#pragma unroll
        for (int bj = 0; bj < 2; ++bj)
#pragma unroll
            for (int n = 0; n < 2; ++n) { const f32x4 bv = bias ? *(const f32x4*)(bias + col0 + bj * HALF + n * 16) : (f32x4){0.f, 0.f, 0.f, 0.f};
#pragma unroll
                for (int ai = 0; ai < 2; ++ai)
#pragma unroll
                    for (int m = 0; m < 4; ++m) acc[ai][bj][m][n] += bv; }
        bool bad = st1.run(acc, u, wr, wc, fr, fq, lds, wid, lane) || poison != 0u;
        const float qnan = __builtin_nanf("");
#pragma unroll
        for (int ai = 0; ai < 2; ++ai)
#pragma unroll
            for (int m = 0; m < 4; ++m) { const int r = ai * HALF + wr * 64 + m * 16 + fr; const f32x2v sr = S[r]; const size_t off = (size_t)(u.pm * BM + r) * ldc + col0;
#pragma unroll
                for (int bj = 0; bj < 2; ++bj)
#pragma unroll
                    for (int n = 0; n < 2; ++n) { const f32x4 bs = *(const f32x4*)(base + off + bj * HALF + n * 16); acc[ai][bj][m][n] = bs + (acc[ai][bj][m][n] - sr.x) * sr.y; }
                asm volatile("" : "+v"(acc[ai][0][m][0]), "+v"(acc[ai][0][m][1]), "+v"(acc[ai][1][m][0]), "+v"(acc[ai][1][m][1]));
                if (m & 1) asm volatile("" ::: "memory"); }
        const bool bad1 = bad;
        bad = st2.run(acc, u, wr, wc, fr, fq, lds, wid, lane) || bad;
#pragma unroll
        for (int ai = 0; ai < 2; ++ai)
#pragma unroll
            for (int m = 0; m < 4; ++m) { const int r = ai * HALF + wr * 64 + m * 16 + fr; const f32x2v sr = S[r]; const size_t off = (size_t)(u.pm * BM + r) * ldc + col0;
#pragma unroll
                for (int bj = 0; bj < 2; ++bj)
#pragma unroll
                    for (int n = 0; n < 2; ++n) { const f32x4 x1 = acc[ai][bj][m][n]; *(f32x4*)(out + off + bj * HALF + n * 16) = bad1 ? (f32x4){qnan, qnan, qnan, qnan} : x1;
                        const f32x4 o = (x1 - sr.x) * sr.y; u32x2v w; w.x = cvt_pk_bf16(o[0], o[1]); w.y = cvt_pk_bf16(o[2], o[3]);
                        if (bad) { w.x = 0x7fc07fc0u; w.y = 0x7fc07fc0u; } *(u32x2v*)(xn + off + bj * HALF + n * 16) = w; }
                asm volatile("" ::: "memory"); }
    }
};

template <class Epi, class Sched, bool ALIGN_EPI = false, bool SP2 = false>
__device__ __forceinline__ void gemm_phase(PG8_LAS unsigned char* lds, const Gemm g, const Sched& S, const Epi& E) {
    int tid_ = threadIdx.x; asm volatile("" : "+v"(tid_));
    const int tid = tid_, wid = __builtin_amdgcn_readfirstlane(tid >> 6), lane = tid & 63, wr = wid >> 2, wc = wid & 3, fr = lane & 15, fq = lane >> 4;
    const int K = g.K, nt = K / BK;
    unsigned voffA[2], voffB[2];
#pragma unroll
    for (int i = 0; i < 2; ++i) { int R, C; stage_rc(tid * 16 + i * 8192, R, C); const int Rb = Epi::PERM ? ((R & ~31) + perm32(R & 31)) : R;
        voffA[i] = (unsigned)(R * K + C) * 2u; voffB[i] = (unsigned)(Rb * K + C) * 2u; }
    const size_t kstep = (size_t)(BK * 2);
    const size_t hstep = (size_t)HALF * K * 2;
    const size_t tstep = 2 * hstep;
    const unsigned ldsw = (unsigned)wid * 1024u;
    const int aoff = lds_byte(wr * 64 + fr, fq * 8), boff = lds_byte(wc * 32 + fr, fq * 8);
#define PG8_SA(b, h) (((b) * 2 + (h)) * HTB)
#define PG8_SB(b, h) ((4 + (b) * 2 + (h)) * HTB)
#define PG8_STAGE(bufoff, gbase, voff) do { _Pragma("unroll") for (int _i = 0; _i < 2; ++_i) \
        __builtin_amdgcn_global_load_lds((const unsigned*)((const char*)(gbase) + (voff)[_i]), (PG8_LAS unsigned*)(lds + (bufoff) + ldsw + _i * 8192), 16, 0, 0); } while (0)
#define PG8_LDA(dst, b, h) do { _Pragma("unroll") for (int m = 0; m < 4; ++m) _Pragma("unroll") for (int k = 0; k < 2; ++k) dst[m][k] = *(const PG8_LAS bf16x8*)(lds + PG8_SA(b, h) + aoff + m * 2048 + k * 1024); } while (0)
#define PG8_LDB(dst, b, h) do { _Pragma("unroll") for (int n = 0; n < 2; ++n) _Pragma("unroll") for (int k = 0; k < 2; ++k) dst[n][k] = *(const PG8_LAS bf16x8*)(lds + PG8_SB(b, h) + boff + n * 2048 + k * 1024); } while (0)
#define PG8_MMA(ai, bj, At, Bt) do { __builtin_amdgcn_s_setprio(1); _Pragma("unroll") for (int m = 0; m < 4; ++m) _Pragma("unroll") for (int n = 0; n < 2; ++n) _Pragma("unroll") for (int k = 0; k < 2; ++k) \
        acc[ai][bj][m][n] = __builtin_amdgcn_mfma_f32_16x16x32_bf16(Bt[n][k], At[m][k], acc[ai][bj][m][n], 0, 0, 0); __builtin_amdgcn_s_setprio(0); } while (0)
#define PG8_WAIT_V(n) asm volatile("s_waitcnt vmcnt(" #n ")" ::: "memory")
#define PG8_WAIT_L(n) asm volatile("s_waitcnt lgkmcnt(" #n ")" ::: "memory")
#define PG8_BAR __builtin_amdgcn_s_barrier()
#define PG8_SCHED __builtin_amdgcn_sched_barrier(0)
    Unit cur, nxt; int ui = 0;
    if (!S.next(0, cur)) return;
    f32x4 acc[2][2][4][2];
#pragma unroll
    for (int a = 0; a < 2; ++a)
#pragma unroll
        for (int b = 0; b < 2; ++b)
#pragma unroll
            for (int m = 0; m < 4; ++m)
#pragma unroll
                for (int n = 0; n < 2; ++n) acc[a][b][m][n] = (f32x4){0.f, 0.f, 0.f, 0.f};
    bf16x8 At[4][2], B0[2][2], B1[2][2];
    const char* cA = (const char*)g.A + (size_t)cur.pm * tstep; const char* cB = (const char*)g.Bt + (size_t)cur.pn * tstep;
    S.a_ready(cur);
    if constexpr (SP2) {
        PG8_STAGE(PG8_SB(0, 0), cB, voffB); PG8_STAGE(PG8_SB(0, 1), cB + hstep, voffB); PG8_STAGE(PG8_SA(0, 0), cA, voffA); PG8_STAGE(PG8_SA(0, 1), cA + hstep, voffA);
        if (wr == 1) PG8_BAR;
        PG8_WAIT_V(2); PG8_BAR;
        PG8_STAGE(PG8_SB(1, 0), cB + kstep, voffB); PG8_STAGE(PG8_SA(1, 0), cA + kstep, voffA); PG8_STAGE(PG8_SB(1, 1), cB + hstep + kstep, voffB);
        PG8_WAIT_V(6); PG8_BAR;
    } else {
        PG8_STAGE(PG8_SB(0, 0), cB, voffB); PG8_STAGE(PG8_SA(0, 0), cA, voffA); PG8_STAGE(PG8_SB(0, 1), cB + hstep, voffB); PG8_STAGE(PG8_SA(0, 1), cA + hstep, voffA);
        if (wr == 1) PG8_BAR;
        PG8_WAIT_V(4); PG8_BAR;
        PG8_STAGE(PG8_SB(1, 0), cB + kstep, voffB); PG8_STAGE(PG8_SA(1, 0), cA + kstep, voffA); PG8_STAGE(PG8_SB(1, 1), cB + hstep + kstep, voffB);
        PG8_WAIT_V(6); PG8_BAR;
    }
    for (;;) {
        const bool has_next = S.next(ui + 1, nxt);
        const char* nA = has_next ? (const char*)g.A + (size_t)nxt.pm * tstep : cA; const char* nB = has_next ? (const char*)g.Bt + (size_t)nxt.pn * tstep : cB;
        for (int t = 0; t < nt; t += 2) {
            const bool last = (t == nt - 2);
            const char* a1 = cA + (size_t)(t + 1) * kstep;
            const char* a2 = last ? nA : cA + (size_t)(t + 2) * kstep; const char* b2 = last ? nB : cB + (size_t)(t + 2) * kstep;
            const char* a3 = a2 + kstep; const char* b3 = b2 + kstep;
            if (last && has_next) S.a_ready(nxt);
            if constexpr (SP2) {
            PG8_LDB(B0, 0, 0); PG8_LDB(B1, 0, 1); PG8_SCHED; PG8_LDA(At, 0, 0); PG8_STAGE(PG8_SA(1, 1), a1 + hstep, voffA);
            PG8_WAIT_V(8); PG8_WAIT_L(0); PG8_BAR; PG8_MMA(0, 0, At, B0); PG8_MMA(0, 1, At, B1); PG8_BAR; PG8_SCHED;
            PG8_LDA(At, 0, 1); PG8_STAGE(PG8_SB(0, 0), b2, voffB); PG8_STAGE(PG8_SB(0, 1), b2 + hstep, voffB); PG8_STAGE(PG8_SA(0, 0), a2, voffA);
            PG8_WAIT_V(8); PG8_WAIT_L(0); PG8_BAR; PG8_MMA(1, 0, At, B0); PG8_MMA(1, 1, At, B1); PG8_BAR; PG8_SCHED;
            PG8_LDB(B0, 1, 0); PG8_LDB(B1, 1, 1); PG8_SCHED; PG8_LDA(At, 1, 0); PG8_STAGE(PG8_SA(0, 1), a2 + hstep, voffA);
            PG8_WAIT_V(8); PG8_WAIT_L(0); PG8_BAR; PG8_MMA(0, 0, At, B0); PG8_MMA(0, 1, At, B1); PG8_BAR; PG8_SCHED;
            PG8_LDA(At, 1, 1); PG8_STAGE(PG8_SB(1, 0), b3, voffB); PG8_STAGE(PG8_SB(1, 1), b3 + hstep, voffB); PG8_STAGE(PG8_SA(1, 0), a3, voffA);
            PG8_WAIT_V(8); PG8_WAIT_L(0); PG8_BAR; PG8_MMA(1, 0, At, B0); PG8_MMA(1, 1, At, B1); PG8_BAR; PG8_SCHED;
            } else {
            PG8_LDB(B0, 0, 0); PG8_SCHED; PG8_LDA(At, 0, 0); PG8_STAGE(PG8_SA(1, 1), a1 + hstep, voffA);
            PG8_WAIT_L(8); PG8_BAR; PG8_WAIT_L(0); PG8_MMA(0, 0, At, B0); PG8_BAR; PG8_SCHED;
            PG8_LDB(B1, 0, 1); PG8_STAGE(PG8_SB(0, 0), b2, voffB);
            PG8_BAR; PG8_WAIT_L(0); PG8_MMA(0, 1, At, B1); PG8_BAR;
            PG8_LDA(At, 0, 1); PG8_STAGE(PG8_SA(0, 0), a2, voffA);
            PG8_BAR; PG8_WAIT_L(0); PG8_MMA(1, 0, At, B0); PG8_BAR; PG8_SCHED;
            PG8_STAGE(PG8_SB(0, 1), b2 + hstep, voffB);
            PG8_WAIT_V(6); PG8_BAR; PG8_MMA(1, 1, At, B1); PG8_BAR;
            PG8_LDB(B0, 1, 0); PG8_SCHED; PG8_LDA(At, 1, 0); PG8_STAGE(PG8_SA(0, 1), a2 + hstep, voffA);
            PG8_WAIT_L(8); PG8_BAR; PG8_WAIT_L(0); PG8_MMA(0, 0, At, B0); PG8_BAR; PG8_SCHED;
            PG8_LDB(B1, 1, 1); PG8_STAGE(PG8_SB(1, 0), b3, voffB);
            PG8_BAR; PG8_WAIT_L(0); PG8_MMA(0, 1, At, B1); PG8_BAR;
            PG8_LDA(At, 1, 1); PG8_STAGE(PG8_SA(1, 0), a3, voffA);
            PG8_BAR; PG8_WAIT_L(0); PG8_MMA(1, 0, At, B0); PG8_BAR; PG8_SCHED;
            PG8_STAGE(PG8_SB(1, 1), b3 + hstep, voffB);
            PG8_WAIT_V(6); PG8_BAR; PG8_MMA(1, 1, At, B1); PG8_BAR;
            }
        }
        if constexpr (ALIGN_EPI) { if (wr == 0) PG8_BAR; }
        if constexpr (!Epi::AFTER_DRAIN) { E(acc, cur, wr, wc, fr, fq); S.done(cur); }
        if (!has_next) break;
#pragma unroll
        for (int a = 0; a < 2; ++a)
#pragma unroll
            for (int b = 0; b < 2; ++b)
#pragma unroll
                for (int m = 0; m < 4; ++m)
#pragma unroll
                    for (int n = 0; n < 2; ++n) acc[a][b][m][n] = (f32x4){0.f, 0.f, 0.f, 0.f};
        cur = nxt; cA = nA; cB = nB; ++ui;
        if constexpr (ALIGN_EPI) { if (wr == 1) PG8_BAR; }
    }
    PG8_WAIT_V(0);
    if constexpr (!ALIGN_EPI) { if (wr == 0) PG8_BAR; }
    PG8_BAR;
    if constexpr (Epi::AFTER_DRAIN) { E.fused(acc, cur, wr, wc, fr, fq, lds, wid, lane); S.done(cur); }
#undef PG8_SA
#undef PG8_SB
#undef PG8_STAGE
#undef PG8_LDA
#undef PG8_LDB
#undef PG8_MMA
#undef PG8_WAIT_V
#undef PG8_WAIT_L
#undef PG8_BAR
#undef PG8_SCHED
}
}

#ifndef PG8_SP2
#define PG8_SP2 true
#endif
#ifndef PG8_ALIGN
#define PG8_ALIGN true
#endif
#include <hip/hip_bf16.h>
#include <cmath>
namespace attn_body {
using bf16=__hip_bfloat16;
using bf16x8=__attribute__((ext_vector_type(8)))short;
using s16x4=__attribute__((ext_vector_type(4)))short;
using f32x16=__attribute__((ext_vector_type(16)))float;
using u32x4=__attribute__((ext_vector_type(4)))unsigned;
constexpr int D=64,PQ=2304,PKV=2304,PO=1024;
constexpr int NW=8,QBLK=32,QB=QBLK*NW,KVBLK=64;
__device__ __forceinline__ int crow(int r,int hi){return (r&3)+8*(r>>2)+4*hi;}
#define SBAR() __builtin_amdgcn_sched_barrier(0)
__device__ __forceinline__ void cmask(f32x16&p0,f32x16&p1,int jb,int qrel,int hi){
  const float NEG=-INFINITY; int kb=64*jb+4*hi;
  #pragma unroll
  for(int r=0;r<16;++r){int kv=kb+(r&3)+8*(r>>2); if(kv>qrel)p0[r]=NEG; if(kv+32>qrel)p1[r]=NEG;}
}

constexpr int NSLOT=3, SLOTB=8192;
constexpr int LDS_K=0, LDS_V=NSLOT*SLOTB, LDS_WS=2*NSLOT*SLOTB, LDS_OST=LDS_WS+NW*64*4, LDS_BYTES=LDS_OST+NW*4096;
constexpr float C2=0.125f*1.4426950408889634f;
__device__ __forceinline__ void glds16(const void*gsrc,unsigned lds_dst){unsigned keep;
  asm volatile("s_mov_b32 %0, m0\n\ts_mov_b32 m0, %2\n\ts_nop 0\n\tglobal_load_lds_dwordx4 %1, off\n\ts_mov_b32 m0, %0":"=&s"(keep):"v"(gsrc),"s"(lds_dst):"memory");}
__device__ __forceinline__ float max3f(float a,float b,float c){float r;asm("v_max3_f32 %0, %1, %2, %3":"=v"(r):"v"(a),"v"(b),"v"(c));return r;}
__device__ __forceinline__ float max2f(float a,float b){float r;asm("v_max_f32_e32 %0, %1, %2":"=v"(r):"v"(a),"v"(b));return r;}
__device__ __forceinline__ float fadd_s(float a,float b){float r;asm("v_add_f32_e32 %0, %1, %2":"=v"(r):"v"(a),"v"(b));return r;}
__device__ __forceinline__ float fsub_s(float a,float b){float r;asm("v_sub_f32_e32 %0, %1, %2":"=v"(r):"v"(a),"v"(b));return r;}
typedef float f32x2_t __attribute__((ext_vector_type(2))); typedef __bf16 bf16x2_t __attribute__((ext_vector_type(2)));
__device__ __forceinline__ unsigned cvtpk_s(float lo,float hi){f32x2_t v={lo,hi};bf16x2_t b=__builtin_convertvector(v,bf16x2_t);return __builtin_bit_cast(unsigned,b);}
#define WAIT_BAR(N) asm volatile("s_waitcnt vmcnt(" #N ") lgkmcnt(0)\n\ts_barrier":::"memory")

__device__ __forceinline__ void qkt(f32x16&p0,f32x16&p1,const char*Kslot,const bf16x8*qr,const f32x16&negm,int r32,int hi){
  const char*kb=Kslot+hi*1024+r32*16;
  #pragma unroll
  for(int d0=0;d0<4;++d0){
    const bf16x8 b0=*reinterpret_cast<const bf16x8*>(kb+d0*2048);
    const bf16x8 b1=*reinterpret_cast<const bf16x8*>(kb+d0*2048+512);
    if(d0==0){p0=__builtin_amdgcn_mfma_f32_32x32x16_bf16(b0,qr[0],negm,0,0,0);p1=__builtin_amdgcn_mfma_f32_32x32x16_bf16(b1,qr[0],negm,0,0,0);}
    else{p0=__builtin_amdgcn_mfma_f32_32x32x16_bf16(b0,qr[d0],p0,0,0,0);p1=__builtin_amdgcn_mfma_f32_32x32x16_bf16(b1,qr[d0],p1,0,0,0);}}
}
typedef __attribute__((address_space(3))) const char* lds_cptr;
typedef short v4i16_t __attribute__((ext_vector_type(4)));
__device__ __forceinline__ void kload8(bf16x8*kf,lds_cptr kp){
  kf[0]=*(const __attribute__((address_space(3))) bf16x8*)(kp);      kf[1]=*(const __attribute__((address_space(3))) bf16x8*)(kp+512);
  kf[2]=*(const __attribute__((address_space(3))) bf16x8*)(kp+2048); kf[3]=*(const __attribute__((address_space(3))) bf16x8*)(kp+2560);
  kf[4]=*(const __attribute__((address_space(3))) bf16x8*)(kp+4096); kf[5]=*(const __attribute__((address_space(3))) bf16x8*)(kp+4608);
  kf[6]=*(const __attribute__((address_space(3))) bf16x8*)(kp+6144); kf[7]=*(const __attribute__((address_space(3))) bf16x8*)(kp+6656);
}
__device__ __forceinline__ void kload2(bf16x8*kf,lds_cptr kp,int j){ kf[2*j]=*(const __attribute__((address_space(3))) bf16x8*)(kp+j*2048); kf[2*j+1]=*(const __attribute__((address_space(3))) bf16x8*)(kp+j*2048+512); }
__device__ __forceinline__ s16x4 vtr(lds_cptr p){ return __builtin_bit_cast(s16x4,__builtin_amdgcn_ds_read_tr16_b64_v4i16((__attribute__((address_space(3))) v4i16_t*)p)); }
__device__ __forceinline__ float rowmax(const f32x16&p0,const f32x16&p1){
  float a=max3f(p0[0],p0[1],p1[0]),b=max3f(p0[2],p0[3],p1[1]);a=max3f(a,p1[2],p1[3]);
  #pragma unroll
  for(int r=4;r<16;r+=4){a=max3f(a,p0[r],p0[r+1]);b=max3f(b,p0[r+2],p0[r+3]);a=max3f(a,p1[r],p1[r+1]);b=max3f(b,p1[r+2],p1[r+3]);}
  const float m=max2f(a,b);
  auto rr=__builtin_amdgcn_permlane32_swap(__float_as_uint(m),__float_as_uint(m),false,false);
  return max2f(__uint_as_float(rr[0]),__uint_as_float(rr[1]));
}
__device__ __forceinline__ void pv(f32x16*o,int vb,bf16x8 pa0,bf16x8 pa1,bf16x8 pa2,bf16x8 pa3){
  #pragma unroll
  for(int d0=0;d0<2;++d0){s16x4 lo[4],hi[4];
    #pragma unroll
    for(int ks=0;ks<4;++ks){
      asm volatile("ds_read_b64_tr_b16 %0,%1 offset:%c2":"=&v"(lo[ks]):"v"(vb),"i"(d0*4096+ks*1024):"memory");
      asm volatile("ds_read_b64_tr_b16 %0,%1 offset:%c2":"=&v"(hi[ks]):"v"(vb),"i"(d0*4096+ks*1024+512):"memory");}
    asm volatile("s_waitcnt lgkmcnt(0)":::"memory");SBAR();
    #define PK(k) (bf16x8){lo[k][0],lo[k][1],lo[k][2],lo[k][3],hi[k][0],hi[k][1],hi[k][2],hi[k][3]}
    o[d0]=__builtin_amdgcn_mfma_f32_32x32x16_bf16(pa0,PK(0),o[d0],0,0,0);
    o[d0]=__builtin_amdgcn_mfma_f32_32x32x16_bf16(pa1,PK(1),o[d0],0,0,0);
    o[d0]=__builtin_amdgcn_mfma_f32_32x32x16_bf16(pa2,PK(2),o[d0],0,0,0);
    o[d0]=__builtin_amdgcn_mfma_f32_32x32x16_bf16(pa3,PK(3),o[d0],0,0,0);
    #undef PK
  }
}

#ifndef ATTN_STORE16
#define ATTN_STORE16(p,v) (*(u32x4*)(p)=(v))
#endif
template<int THRL,int NT> __device__ __forceinline__ void attn_unit(int qb,const bf16*Qh,const bf16*__restrict__ Kh,const bf16*__restrict__ Vh,bf16*Oh,char*shm){
  int tid_=threadIdx.x; asm volatile("":"+v"(tid_)); const int tid=tid_,lane=tid&63,r32=lane&31,hi=lane>>5; const int wid=__builtin_amdgcn_readfirstlane(tid>>6);
  const int q0=qb*QB;
  const bf16*Qw=Qh+(long)(q0+wid*QBLK)*PQ;
  const unsigned lds0=(unsigned)(uintptr_t)shm;
  float*wsf=(float*)(shm+LDS_WS)+wid*64;
  const bf16*ksrc=Kh+(long)lane*PKV+wid*8;
  const bf16*vsrc=Vh+(long)(16*(wid&3)+(lane>>2))*PKV+(wid>>2)*32+(lane&3)*8;
  const unsigned kdst=lds0+LDS_K+wid*1024, vdst=lds0+LDS_V+wid*1024;
  #define DMA_K(t,slot) glds16(ksrc+(long)(t)*KVBLK*PKV,(unsigned)__builtin_amdgcn_readfirstlane(kdst+(slot)))
  #define DMA_V(t,slot) glds16(vsrc+(long)(t)*KVBLK*PKV,(unsigned)__builtin_amdgcn_readfirstlane(vdst+(slot)))
  const int vb0=(int)(lds0+LDS_V)+((lane>>4)&1)*32+(lane&3)*8+(4*hi+((lane&15)>>2))*64;
  const char*Kbase=shm+LDS_K; bf16x8 kf[8];
  const lds_cptr shm3=(lds_cptr)shm; const lds_cptr kp0=shm3+LDS_K+hi*1024+r32*16; const lds_cptr vp0=shm3+LDS_V+((lane>>4)&1)*32+(lane&3)*8+(4*hi+((lane&15)>>2))*64;
  DMA_K(0,0);DMA_V(0,0);DMA_K(1,SLOTB);
  bf16x8 qr[4];
  #pragma unroll
  for(int d0=0;d0<4;++d0)qr[d0]=*reinterpret_cast<const bf16x8*>(&Qw[(long)r32*PQ+d0*16+hi*8]);
  float mhat=0.f,l_reg=0.f;f32x16 o[2];o[0]=f32x16{};o[1]=f32x16{};f32x16 negm=f32x16{};asm volatile("":"+v"(negm));
  #define CMASK(P0,P1,t) do{}while(0)
  bool resc=false;
  #define START(P0,P1) do{ const float rm=rowmax(P0,P1); resc=false; \
    { const float dl=rm; mhat=fadd_s(mhat,dl); \
      _Pragma("unroll") for(int r=0;r<16;++r){P0[r]=fsub_s(P0[r],dl);P1[r]=fsub_s(P1[r],dl);} \
      _Pragma("unroll") for(int r=0;r<16;++r)negm[r]=-mhat; asm volatile("":"+v"(negm)); } \
    _Pragma("unroll") for(int r=0;r<16;++r)P0[r]=__builtin_amdgcn_exp2f(P0[r]); }while(0)
  #define RESC() do{ if(resc){ asm volatile("s_waitcnt lgkmcnt(0)":::"memory"); \
      _Pragma("unroll") for(int d_=0;d_<2;++d_) _Pragma("unroll") for(int r=0;r<16;++r)o[d_][r]*=wsf[crow(r,hi)]; } }while(0)
  f32x16 pA0,pA1,pB0,pB1;
  int sl_prev=0,sl_cur=0,sl_next=SLOTB;
  #define ROT() do{sl_prev=sl_cur;sl_cur=sl_next;sl_next=(sl_next==(NSLOT-1)*SLOTB)?0:sl_next+SLOTB;}while(0)
  DMA_K(2,2*SLOTB);
  WAIT_BAR(3);
  qkt(pA0,pA1,Kbase,qr,negm,r32,hi);asm volatile("s_nop 15\n\ts_nop 7":"+v"(pA0),"+v"(pA1));CMASK(pA0,pA1,0);
  START(pA0,pA1);
  _Pragma("unroll") for(int r=0;r<16;++r)pA1[r]=__builtin_amdgcn_exp2f(pA1[r]);
  WAIT_BAR(0);
  DMA_K(3,0);DMA_V(1,SLOTB);
  ROT();
  kload8(kf,kp0+sl_cur);
  WAIT_BAR(2);
  s16x4 vlo[8],vhi[8]; u32x4 pw0,pw1,pw2,pw3;
  #define PKW(P,B) cvtpk_s(P[B],P[B+1])
  #define PAF(k) __builtin_bit_cast(bf16x8,pw##k)
  #define VFR(i) (bf16x8){vlo[i][0],vlo[i][1],vlo[i][2],vlo[i][3],vhi[i][0],vhi[i][1],vhi[i][2],vhi[i][3]}
  #define PIN(x) asm volatile("":"+v"(x))
  #define MX3(a,b,c) __builtin_fmaxf(__builtin_fmaxf((a),(b)),(c))
  #define GAPA(MF,A0,A1,A2,A3,W0,W1,PW) do{ MF; sacc+=A0; sacc+=A1; sacc+=A2; sacc+=A3; PIN(sacc); W0; W1; PIN(PW); SBAR(); }while(0)
  #define EX(v) __builtin_amdgcn_exp2f(v)
  #define GAPB(MF,X,B) do{ MF; X[B]=EX(X[B]); X[B+1]=EX(X[B+1]); X[B+2]=EX(X[B+2]); X[B+3]=EX(X[B+3]); PIN(X); SBAR(); }while(0)
  #define VRD(i) do{ vlo[i]=vtr(vp_+(((i)>>2)*4096+((i)&3)*1024)); vhi[i]=vtr(vp_+(((i)>>2)*4096+((i)&3)*1024+512)); }while(0)
  #define KRD(G,j) do{ if(G){ kload2(kf,kp0+sl_next,j); SBAR(); } }while(0)
  #define STEP(C0,C1,P0,P1,t,GK,GV,GL) do{ SBAR(); \
    const lds_cptr vp_=vp0+sl_prev; \
    VRD(0); SBAR(); float sacc=(P0[0]+P0[1]); \
    GAPA(C0=__builtin_amdgcn_mfma_f32_32x32x16_bf16(kf[0],qr[0],negm,0,0,0), P0[2],P0[3],P0[4],P0[5],     pw0[0]=PKW(P0,0), pw0[1]=PKW(P0,2), pw0); \
    VRD(4); SBAR(); GAPA(C1=__builtin_amdgcn_mfma_f32_32x32x16_bf16(kf[1],qr[0],negm,0,0,0), P0[6],P0[7],P0[8],P0[9],     pw0[2]=PKW(P0,4), pw0[3]=PKW(P0,6), pw0); \
    VRD(1); SBAR(); GAPA(C0=__builtin_amdgcn_mfma_f32_32x32x16_bf16(kf[2],qr[1],C0,0,0,0),   P0[10],P0[11],P0[12],P0[13], pw1[0]=PKW(P0,8), pw1[1]=PKW(P0,10), pw1); \
    VRD(5); SBAR(); GAPA(C1=__builtin_amdgcn_mfma_f32_32x32x16_bf16(kf[3],qr[1],C1,0,0,0),   P0[14],P0[15],P1[0],P1[1],   pw1[2]=PKW(P0,12),pw1[3]=PKW(P0,14), pw1); \
    VRD(2); SBAR(); GAPA(C0=__builtin_amdgcn_mfma_f32_32x32x16_bf16(kf[4],qr[2],C0,0,0,0),   P1[2],P1[3],P1[4],P1[5],     pw2[0]=PKW(P1,0), pw2[1]=PKW(P1,2), pw2); \
    VRD(6); SBAR(); GAPA(C1=__builtin_amdgcn_mfma_f32_32x32x16_bf16(kf[5],qr[2],C1,0,0,0),   P1[6],P1[7],P1[8],P1[9],     pw2[2]=PKW(P1,4), pw2[3]=PKW(P1,6), pw2); \
    VRD(3); SBAR(); GAPA(C0=__builtin_amdgcn_mfma_f32_32x32x16_bf16(kf[6],qr[3],C0,0,0,0),   P1[10],P1[11],P1[12],P1[13], pw3[0]=PKW(P1,8), pw3[1]=PKW(P1,10), pw3); \
    VRD(7); SBAR(); GAPA(C1=__builtin_amdgcn_mfma_f32_32x32x16_bf16(kf[7],qr[3],C1,0,0,0),   P1[14],P1[15],0.f,0.f,       pw3[2]=PKW(P1,12),pw3[3]=PKW(P1,14), pw3); \
    l_reg+=sacc; \
    if(GK){DMA_K((t)+3,sl_cur);} if(GV){DMA_V((t)+1,sl_next);} \
    CMASK(C0,C1,t); \
    { float a=MX3(C0[0],C0[1],C1[0]),b=MX3(C0[2],C0[3],C1[1]); a=MX3(a,C1[2],C1[3]); \
      _Pragma("unroll") for(int r=4;r<16;r+=4){a=MX3(a,C0[r],C0[r+1]);b=MX3(b,C0[r+2],C0[r+3]);a=MX3(a,C1[r],C1[r+1]);b=MX3(b,C1[r+2],C1[r+3]);} \
      float rm=__builtin_fmaxf(a,b); { auto rr=__builtin_amdgcn_permlane32_swap(__float_as_uint(rm),__float_as_uint(rm),false,false); rm=__builtin_fmaxf(__uint_as_float(rr[0]),__uint_as_float(rr[1])); } \
      resc=false; \
      if(__builtin_expect(__any(rm>(float)THRL),0)){ const float dl=__builtin_fmaxf(rm,0.f); mhat+=dl; \
        _Pragma("unroll") for(int r=0;r<16;++r){C0[r]-=dl;C1[r]-=dl;} \
        _Pragma("unroll") for(int r=0;r<16;++r)negm[r]=-mhat; asm volatile("":"+v"(negm)); \
        const float f=__builtin_amdgcn_exp2f(-dl); l_reg*=f; if(hi==0)wsf[r32]=f; resc=true; } } \
    SBAR(); \
    GAPB(o[0]=__builtin_amdgcn_mfma_f32_32x32x16_bf16(PAF(0),VFR(0),o[0],0,0,0), C0,0); \
    GAPB(o[1]=__builtin_amdgcn_mfma_f32_32x32x16_bf16(PAF(0),VFR(4),o[1],0,0,0), C0,4); \
    KRD(GL,0); GAPB(o[0]=__builtin_amdgcn_mfma_f32_32x32x16_bf16(PAF(1),VFR(1),o[0],0,0,0), C0,8); \
    KRD(GL,1); GAPB(o[1]=__builtin_amdgcn_mfma_f32_32x32x16_bf16(PAF(1),VFR(5),o[1],0,0,0), C0,12); \
    KRD(GL,2); GAPB(o[0]=__builtin_amdgcn_mfma_f32_32x32x16_bf16(PAF(2),VFR(2),o[0],0,0,0), C1,0); \
    KRD(GL,3); GAPB(o[1]=__builtin_amdgcn_mfma_f32_32x32x16_bf16(PAF(2),VFR(6),o[1],0,0,0), C1,4); \
    GAPB(o[0]=__builtin_amdgcn_mfma_f32_32x32x16_bf16(PAF(3),VFR(3),o[0],0,0,0), C1,8); \
    GAPB(o[1]=__builtin_amdgcn_mfma_f32_32x32x16_bf16(PAF(3),VFR(7),o[1],0,0,0), C1,12); \
    }while(0)
  int t=1;
  #undef CMASK
  #define CMASK(P0,P1,t) do{}while(0)
  for(;t+5<NT;t+=2){
    STEP(pB0,pB1,pA0,pA1,t,true,true,true);     WAIT_BAR(2); RESC(); ROT();
    STEP(pA0,pA1,pB0,pB1,t+1,true,true,true);   WAIT_BAR(2); RESC(); ROT();
  }
  #undef CMASK
  #define CMASK(P0,P1,t) do{}while(0)
  #define ENDW(tt) do{ if((tt)+3<NT){WAIT_BAR(2);} else if((tt)+2<NT){WAIT_BAR(1);} else {WAIT_BAR(0);} }while(0)
  for(;t+1<NT;t+=2){
    STEP(pB0,pB1,pA0,pA1,t,(t+3<NT),(t+1<NT),(t+1<NT));       ENDW(t);   RESC(); ROT();
    STEP(pA0,pA1,pB0,pB1,t+1,(t+4<NT),(t+2<NT),(t+2<NT));     ENDW(t+1); RESC(); ROT();
  }
  STEP(pB0,pB1,pA0,pA1,NT-1,false,false,false); RESC();
  { float sacc=pB0[0]+pB0[1]; _Pragma("unroll") for(int r=2;r<16;++r)sacc+=pB0[r]; _Pragma("unroll") for(int r=0;r<16;++r)sacc+=pB1[r]; l_reg+=sacc;
    pw0=(u32x4){PKW(pB0,0),PKW(pB0,2),PKW(pB0,4),PKW(pB0,6)};pw1=(u32x4){PKW(pB0,8),PKW(pB0,10),PKW(pB0,12),PKW(pB0,14)};pw2=(u32x4){PKW(pB1,0),PKW(pB1,2),PKW(pB1,4),PKW(pB1,6)};pw3=(u32x4){PKW(pB1,8),PKW(pB1,10),PKW(pB1,12),PKW(pB1,14)};
    SBAR(); pv(o,vb0+sl_cur,PAF(0),PAF(1),PAF(2),PAF(3)); }
  #undef PKW
  #undef PAF
  #undef VFR
  #undef PIN
  #undef MX3
  #undef GAPA
  #undef GAPB
  #undef EX
  #undef VRD
  #undef KRD
  #undef STEP
  #undef ENDW
  {auto rr=__builtin_amdgcn_permlane32_swap(__float_as_uint(l_reg),__float_as_uint(l_reg),false,false);l_reg=__uint_as_float(rr[0])+__uint_as_float(rr[1]);}
  if(hi==0)wsf[32+r32]=l_reg;asm volatile("s_waitcnt lgkmcnt(0)":::"memory");
  float rli[16];
  #pragma unroll
  for(int r=0;r<16;++r)rli[r]=__builtin_amdgcn_rcpf(wsf[32+crow(r,hi)]);
  bf16*Ow=Oh+(long)(q0+wid*QBLK)*PO;
  { bf16*stg=(bf16*)(shm+LDS_OST)+wid*2048;
    #pragma unroll
    for(int r=0;r<16;++r){const int orow=crow(r,hi);
      #pragma unroll
      for(int d0=0;d0<2;++d0)stg[orow*64+d0*32+r32]=__float2bfloat16(o[d0][r]*rli[r]);}
    asm volatile("s_waitcnt lgkmcnt(0)":::"memory");
    #pragma unroll
    for(int i=0;i<4;++i){const int row=i*8+(lane>>3),ch=lane&7; const u32x4 v=*(const u32x4*)(stg+row*64+ch*8); ATTN_STORE16(Ow+(long)row*PO+ch*8,v);} }
  asm volatile("s_waitcnt lgkmcnt(0)\n\ts_barrier":::"memory");
  #undef DMA_K
  #undef DMA_V
  #undef CMASK
  #undef START
  #undef RESC
  #undef ROT
}
constexpr int ATTN_LDS_BYTES=LDS_BYTES;
#undef SBAR
#undef WAIT_BAR
}
namespace cg = cooperative_groups;
#define LAS __attribute__((address_space(3)))
typedef unsigned short bf16;
typedef unsigned v4u __attribute__((ext_vector_type(4)));
typedef unsigned v2u __attribute__((ext_vector_type(2)));
typedef float f32x4 __attribute__((ext_vector_type(4)));
typedef float f32x16 __attribute__((ext_vector_type(16)));
typedef short bf16x8 __attribute__((ext_vector_type(8)));
typedef short s16x4 __attribute__((ext_vector_type(4)));

constexpr int DM = 1024, MP = 16384, MS = 65536, MT = MP + MS, SP = 2048, SS = 8192;
constexpr int ABIN = 2304, CIN = 5120, DFF = 2816, DFF2 = 5632;
constexpr int NTHREADS = 512, NWAVES = 8;
constexpr int LDS_BYTES = 147456;
constexpr float ALPHA = 1.41421356237f;
constexpr float C2 = 0.125f * 1.4426950408889634f;
constexpr size_t MiB = 1u << 20;
constexpr size_t WS_W_INAB = 1 * MiB;
constexpr size_t WS_W_OUTAB = WS_W_INAB + (size_t)ABIN * DM * 2;
constexpr size_t WS_W_INC = WS_W_OUTAB + (size_t)DM * DM * 2;
constexpr size_t WS_W_OUTC = WS_W_INC + (size_t)CIN * DM * 2;
constexpr size_t WS_W_UP = WS_W_OUTC + (size_t)DM * DM * 2;
constexpr size_t WS_W_DN = WS_W_UP + 2 * (size_t)DFF2 * DM * 2;
constexpr size_t WS_W_END = WS_W_DN + 2 * (size_t)DM * DFF * 2;
constexpr size_t WS_TAB = 56 * MiB;
constexpr size_t WS_XN = 57 * MiB;
constexpr size_t WS_BIG = 217 * MiB;
constexpr size_t WS_HAB = WS_BIG;
constexpr size_t WS_YAT = WS_BIG + 360 * MiB;
constexpr size_t WS_HFF = WS_BIG;
constexpr size_t WS_HACT = WS_BIG + 440 * MiB;
constexpr size_t WS_PL = WS_BIG;
constexpr size_t PLANE = (size_t)MT * DM;
constexpr size_t WS_NEED = WS_BIG + 800 * MiB;
static_assert(WS_W_END <= WS_TAB, "weights fit");
constexpr int FCH = 40960;

struct Params {
    const float *xp, *xs, *w_in_ab, *w_out_ab, *qn, *kn, *w_in_c, *w_out_c, *lbf, *lbb, *gn, *lnmg, *lnmb, *lnfg, *lnfb, *wup, *cw, *cb, *wdn;
    float* out; unsigned char* ws;
    float fa[8]; float fb[16];
};

typedef const __attribute__((address_space(4))) Params* CP;
#define FRESH_P() ({ CP p_ = (CP)__builtin_amdgcn_kernarg_segment_ptr(); asm volatile("" : "+s"(p_)); p_; })
__device__ __forceinline__ unsigned f2bf(float f) { unsigned u = __builtin_bit_cast(unsigned, f); return (u + 0x7fffu + ((u >> 16) & 1u)) >> 16; }
__device__ __forceinline__ unsigned pk2(float lo, float hi) { return f2bf(lo) | (f2bf(hi) << 16); }
__device__ __forceinline__ float bf2f(unsigned b) { return __builtin_bit_cast(float, b << 16); }
__device__ __forceinline__ float bflo(unsigned w) { return __builtin_bit_cast(float, w << 16); }
__device__ __forceinline__ float bfhi(unsigned w) { return __builtin_bit_cast(float, w & 0xffff0000u); }
__device__ __forceinline__ float ex2(float x) { return __builtin_amdgcn_exp2f(x); }
__device__ __forceinline__ float wave_sum(float v) {
#pragma unroll
    for (int o = 1; o < 64; o <<= 1) v += __shfl_xor(v, o);
    return v;
}
#define MFMA32(a, b, c) __builtin_amdgcn_mfma_f32_32x32x16_bf16((a), (b), (c), 0, 0, 0)
__device__ __forceinline__ int crow(int r, int hi) { return (r & 3) + 8 * (r >> 2) + 4 * hi; }
__device__ __forceinline__ bf16x8 pack8(const f32x16& x, int s) {
    v4u p; p.x = pk2(x[8 * s], x[8 * s + 1]); p.y = pk2(x[8 * s + 2], x[8 * s + 3]); p.z = pk2(x[8 * s + 4], x[8 * s + 5]); p.w = pk2(x[8 * s + 6], x[8 * s + 7]);
    return __builtin_bit_cast(bf16x8, p);
}

template <int MODE> struct EpiRes {
    static constexpr bool PERM = false, AFTER_DRAIN = false;
    const float* b0; const float* b1; int split_row; const bf16* bx; float* out;
    __device__ __forceinline__ void operator()(const pg8::f32x4 (&acc)[2][2][4][2], const pg8::Unit& u, int wr, int wc, int fr, int fq) const {
        const int col0 = u.pn * 256 + wc * 32 + 4 * fq;
#pragma unroll
        for (int ai = 0; ai < 2; ++ai)
#pragma unroll
            for (int m = 0; m < 4; ++m) {
                const int row = u.pm * 256 + ai * 128 + wr * 64 + m * 16 + fr;
                float* op = out + (size_t)row * DM + col0;
                if (MODE == 0) {
                    const float* bp = (row < split_row ? b0 + (size_t)row * DM : b1 + (size_t)(row - split_row) * DM) + col0;
#pragma unroll
                    for (int bj = 0; bj < 2; ++bj)
#pragma unroll
                        for (int n = 0; n < 2; ++n) { const f32x4 bs = *(const f32x4*)(bp + bj * 128 + n * 16); *(f32x4*)(op + bj * 128 + n * 16) = bs * ALPHA + acc[ai][bj][m][n]; }
                } else {
                    const bf16* bp = bx + (size_t)row * DM + col0;
#pragma unroll
                    for (int bj = 0; bj < 2; ++bj)
#pragma unroll
                        for (int n = 0; n < 2; ++n) { const v2u w = *(const v2u*)(bp + bj * 128 + n * 16); f32x4 bs = {bflo(w.x), bfhi(w.x), bflo(w.y), bfhi(w.y)}; *(f32x4*)(op + bj * 128 + n * 16) = bs * ALPHA + acc[ai][bj][m][n]; }
                }
            }
    }
};

__device__ __forceinline__ void p0_transpose_item(const float* W, int K, int N, bf16* WT, LAS float* scr, int item, int lane) {
    const int nblk = N / 32, kb = item / nblk, nb = item % nblk, k0 = 64 * kb, n0 = 32 * nb;
#pragma unroll 8
    for (int i = 0; i < 32; ++i) { const int kk = 2 * i + (lane >> 5); scr[kk * 33 + (lane & 31)] = W[(size_t)(k0 + kk) * N + n0 + (lane & 31)]; }
    asm volatile("s_waitcnt lgkmcnt(0)" ::: "memory");
    const int c = lane & 7;
#pragma unroll
    for (int j = 0; j < 4; ++j) { const int n = (lane >> 3) + 8 * j; const LAS float* s = scr + (8 * c) * 33 + n;
        v4u o; o.x = pk2(s[0 * 33], s[1 * 33]); o.y = pk2(s[2 * 33], s[3 * 33]); o.z = pk2(s[4 * 33], s[5 * 33]); o.w = pk2(s[6 * 33], s[7 * 33]);
        *(v4u*)(WT + (size_t)(n0 + n) * K + k0 + 8 * c) = o; }
    asm volatile("s_waitcnt lgkmcnt(0)" ::: "memory");
}
__device__ __forceinline__ void sincos_rev(int pos, float f, float& c, float& s) {
    const float p = (float)pos, hi = p * f, lo = __builtin_fmaf(p, f, -hi);
    const float fr = (hi - __builtin_floorf(hi)) + lo;
    c = __builtin_amdgcn_cosf(fr); s = __builtin_amdgcn_sinf(fr);
}
__device__ __forceinline__ void phase_prologue(CP P, LAS unsigned char* lds, int gw, int NGW, int lane, int wave) {
    unsigned char* ws = P->ws;
    LAS float* scr = (LAS float*)(lds + wave * 16384);
    constexpr int I0 = 16 * (ABIN / 32), I1 = 16 * 32, I2 = 16 * (CIN / 32), I3 = 16 * 32, I4 = 16 * (DFF2 / 32), I6 = (DFF / 64) * 32;
    constexpr int NIT = I0 + I1 + I2 + I3 + 2 * I4 + 2 * I6;
    for (int it = gw; it < NIT; it += NGW) {
        int r = it;
        if (r < I0) { p0_transpose_item(P->w_in_ab, DM, ABIN, (bf16*)(ws + WS_W_INAB), scr, r, lane); continue; } r -= I0;
        if (r < I1) { p0_transpose_item(P->w_out_ab, DM, DM, (bf16*)(ws + WS_W_OUTAB), scr, r, lane); continue; } r -= I1;
        if (r < I2) { p0_transpose_item(P->w_in_c, DM, CIN, (bf16*)(ws + WS_W_INC), scr, r, lane); continue; } r -= I2;
        if (r < I3) { p0_transpose_item(P->w_out_c, DM, DM, (bf16*)(ws + WS_W_OUTC), scr, r, lane); continue; } r -= I3;
        if (r < 2 * I4) { const int l = r / I4; p0_transpose_item(P->wup + (size_t)l * DM * DFF2, DM, DFF2, (bf16*)(ws + WS_W_UP) + (size_t)l * DFF2 * DM, scr, r % I4, lane); continue; } r -= 2 * I4;
        { const int l = r / I6; p0_transpose_item(P->wdn + (size_t)l * DFF * DM, DFF, DM, (bf16*)(ws + WS_W_DN) + (size_t)l * DM * DFF, scr, r % I6, lane); }
    }
    bf16* XN = (bf16*)(ws + WS_XN);
    for (int m = gw; m < MT; m += NGW) {
        const float* xr = (m < MP) ? P->xp + (size_t)m * DM : P->xs + (size_t)(m - MP) * DM;
        const f32x4* x4 = (const f32x4*)xr + lane; v2u* o = (v2u*)(XN + (size_t)m * DM) + lane;
#pragma unroll
        for (int j = 0; j < 4; ++j) { const f32x4 v = x4[64 * j]; v2u w; w.x = pk2(v.x, v.y); w.y = pk2(v.z, v.w); o[64 * j] = w; }
    }
    float2* TA = (float2*)(ws + WS_TAB); float2* TR = TA + 8192 * 8; float2* TC = TR + 128 * 16;
    const int gt = gw * 64 + lane, NT_ = NGW * 64;
    for (int i = gt; i < 8192 * 8; i += NT_) { float c, s; sincos_rev(i >> 3, P->fa[i & 7], c, s); TA[i] = make_float2(c, s); }
    for (int i = gt; i < 128 * 16; i += NT_) { float c, s; sincos_rev(i >> 4, P->fb[i & 15], c, s); TR[i] = make_float2(c, s); }
    for (int i = gt; i < 64 * 16; i += NT_) { float c, s; sincos_rev(i >> 4, P->fb[i & 15], c, s); TC[i] = make_float2(c, s); }
}

__device__ __forceinline__ void phase_prep(CP P, int gw, int NGW, int lane) {
    unsigned char* ws = P->ws; bf16* H = (bf16*)(ws + WS_HAB);
    const float2* TA = (const float2*)(ws + WS_TAB); const float2* TR = TA + 8192 * 8; const float2* TC = TR + 128 * 16;
    const int slot = lane >> 3, j = lane & 7;
    for (int item = gw; item < MT * 4; item += NGW) {
        const int m = item >> 2, sg = item & 3;
        const int t = (m < MP) ? (m & (SP - 1)) : ((m - MP) & (SS - 1));
        bool active = true; int col;
        if (sg == 0) col = 64 * slot; else if (sg == 1) col = 512 + 64 * slot; else if (sg == 2) col = 1536 + 64 * slot;
        else { active = slot < 2; col = 2048 + 64 * (slot & 1); }
        bf16* p = H + (size_t)m * ABIN + col + 8 * j;
        const v4u raw = *(const v4u*)p;
        float x[8] = {bflo(raw.x), bfhi(raw.x), bflo(raw.y), bfhi(raw.y), bflo(raw.z), bfhi(raw.z), bflo(raw.w), bfhi(raw.w)};
        float o[8];
        if (sg < 2) {
            active = j < 2;
#pragma unroll
            for (int e = 0; e < 8; ++e) { const float y = __shfl_xor(x[e], 1); const float2 cs = TA[t * 8 + e]; o[e] = (j & 1) ? x[e] * cs.x + y * cs.y : x[e] * cs.x - y * cs.y; }
        } else {
            float ss = 0.f;
#pragma unroll
            for (int e = 0; e < 8; ++e) ss += x[e] * x[e];
            ss += __shfl_xor(ss, 1); ss += __shfl_xor(ss, 2); ss += __shfl_xor(ss, 4);
            const float r = 1.0f / sqrtf(ss * (1.0f / 64.0f) + 1e-6f);
            const float* gain = (sg == 2 ? P->qn : P->kn) + 8 * j;
            const int pos = (j < 4) ? (t >> 6) : (t & 63); const float2* T = (j < 4 ? TR : TC) + pos * 16 + 8 * (j & 1);
            const float sc = (sg == 2) ? C2 : 1.0f;
#pragma unroll
            for (int e = 0; e < 8; ++e) x[e] = x[e] * r * gain[e];
#pragma unroll
            for (int e = 0; e < 8; ++e) { const float y = __shfl_xor(x[e], 2); const float2 cs = T[e]; o[e] = ((j & 2) ? x[e] * cs.x + y * cs.y : x[e] * cs.x - y * cs.y) * sc; }
        }
        if (active) { v4u w; w.x = pk2(o[0], o[1]); w.y = pk2(o[2], o[3]); w.z = pk2(o[4], o[5]); w.w = pk2(o[6], o[7]); *(v4u*)p = w; }
    }
}

__device__ __forceinline__ void dilated_unit(const bf16* H, bf16* Y, int R0, int S, int h, int sp, LAS unsigned char* lds, int tid, int wave, int lane) {
    LAS float* ACC = (LAS float*)lds;
    LAS float* MX = ACC + 512 * 65;
    LAS float* LX = MX + 512;
    LAS float* WSM = LX + 512 + wave * 64;
    const int r32 = lane & 31, hi = lane >> 5;
#pragma unroll 1
    for (int g = 0; g < 3; ++g) {
        const int dil = (g == 0) ? 1 : (g == 1 ? 4 : 16), m = S / dil;
#pragma unroll 1
        for (int tk = wave; tk < 16; tk += 8) {
            const int c = tk % dil, blk = tk / dil, i0 = (512 / dil) * sp + 32 * blk;
            const bf16* Qp = H + (size_t)(R0 + c + dil * (i0 + r32)) * ABIN + 64 * h + 8 * hi;
            bf16x8 qf[4];
#pragma unroll
            for (int d0 = 0; d0 < 4; ++d0) qf[d0] = *(const bf16x8*)(Qp + 16 * d0);
            f32x16 st[5];
#pragma unroll
            for (int jt = 0; jt < 5; ++jt) {
                int ik = i0 - 64 + 32 * jt + r32; ik = ik < 0 ? 0 : (ik >= m ? m - 1 : ik);
                const bf16* Kp = H + (size_t)(R0 + c + dil * ik) * ABIN + 512 + 64 * h + 8 * hi;
                bf16x8 kf[4];
#pragma unroll
                for (int d0 = 0; d0 < 4; ++d0) kf[d0] = *(const bf16x8*)(Kp + 16 * d0);
                f32x16 a = {};
#pragma unroll
                for (int d0 = 0; d0 < 4; ++d0) a = MFMA32(kf[d0], qf[d0], a);
                st[jt] = a;
            }
            float mx = -INFINITY;
#pragma unroll
            for (int jt = 0; jt < 5; ++jt)
#pragma unroll
                for (int r = 0; r < 16; ++r) {
                    const int kq = -64 + 32 * jt + crow(r, hi), rel = kq - r32, ikr = i0 + kq;
                    const bool ok = (rel <= 64) && (rel >= -64) && (ikr >= 0) && (ikr < m);
                    const float s = ok ? st[jt][r] * C2 : -INFINITY; st[jt][r] = s; mx = fmaxf(mx, s);
                }
            mx = fmaxf(mx, __shfl_xor(mx, 32));
            float l = 0.f;
#pragma unroll
            for (int jt = 0; jt < 5; ++jt)
#pragma unroll
                for (int r = 0; r < 16; ++r) { const float p = ex2(st[jt][r] - mx); st[jt][r] = p; l += p; }
            l += __shfl_xor(l, 32);
            f32x16 o0 = {}, o1 = {};
#pragma unroll
            for (int jt = 0; jt < 5; ++jt)
#pragma unroll
                for (int s = 0; s < 2; ++s) {
                    const bf16x8 pa = pack8(st[jt], s);
                    bf16x8 v0, v1;
#pragma unroll
                    for (int jj = 0; jj < 8; ++jj) {
                        int ik = i0 - 64 + 32 * jt + 16 * s + 8 * (jj >> 2) + 4 * hi + (jj & 3); ik = ik < 0 ? 0 : (ik >= m ? m - 1 : ik);
                        const bf16* Vp = H + (size_t)(R0 + c + dil * ik) * ABIN + 1024 + 64 * h + r32;
                        v0[jj] = (short)Vp[0]; v1[jj] = (short)Vp[32];
                    }
                    o0 = MFMA32(pa, v0, o0); o1 = MFMA32(pa, v1, o1);
                }
            if (hi == 0) { WSM[r32] = mx; WSM[32 + r32] = l; }
            asm volatile("s_waitcnt lgkmcnt(0)" ::: "memory");
#pragma unroll
            for (int r = 0; r < 16; ++r) {
                const int q = crow(r, hi); const float mt = WSM[q], lt = WSM[32 + q];
                const int tl = c + dil * (i0 + q) - 512 * sp;
                LAS float* ap = ACC + tl * 65 + r32;
                if (g == 0) { ap[0] = o0[r]; ap[32] = o1[r]; if (r32 == 0) { MX[tl] = mt; LX[tl] = lt; } }
                else {
                    const float mo = MX[tl], lo = LX[tl], mn = fmaxf(mo, mt), so = ex2(mo - mn), sn = ex2(mt - mn);
                    ap[0] = ap[0] * so + o0[r] * sn; ap[32] = ap[32] * so + o1[r] * sn;
                    asm volatile("s_waitcnt lgkmcnt(0)" ::: "memory");
                    if (r32 == 0) { MX[tl] = mn; LX[tl] = lo * so + lt * sn; }
                }
            }
            asm volatile("s_waitcnt lgkmcnt(0)" ::: "memory");
        }
        __syncthreads();
    }
    {
        const float inv = 1.0f / LX[tid]; const LAS float* ap = ACC + tid * 65;
        bf16* yp = Y + (size_t)(R0 + 512 * sp + tid) * DM + 64 * h;
#pragma unroll
        for (int c8 = 0; c8 < 8; ++c8) { v4u w; w.x = pk2(ap[8 * c8] * inv, ap[8 * c8 + 1] * inv); w.y = pk2(ap[8 * c8 + 2] * inv, ap[8 * c8 + 3] * inv);
            w.z = pk2(ap[8 * c8 + 4] * inv, ap[8 * c8 + 5] * inv); w.w = pk2(ap[8 * c8 + 6] * inv, ap[8 * c8 + 7] * inv); *(v4u*)(yp + 8 * c8) = w; }
    }
    __syncthreads();
}

__device__ __forceinline__ void phase_ln(float* X, bf16* XN, const float* g, const float* b, int gw, int NGW, int lane) {
    f32x4 gv[4], bv[4];
#pragma unroll
    for (int j = 0; j < 4; ++j) { gv[j] = ((const f32x4*)g)[lane + 64 * j]; bv[j] = ((const f32x4*)b)[lane + 64 * j]; }
    for (int m = gw; m < MT; m += NGW) {
        f32x4* xr = (f32x4*)(X + (size_t)m * DM) + lane;
        f32x4 v[4]; float s = 0.f;
#pragma unroll
        for (int j = 0; j < 4; ++j) { v[j] = xr[64 * j]; s += (v[j].x + v[j].y) + (v[j].z + v[j].w); }
        const float mean = wave_sum(s) * (1.f / DM); float s2 = 0.f;
#pragma unroll
        for (int j = 0; j < 4; ++j) { v[j] = v[j] - mean; s2 += (v[j].x * v[j].x + v[j].y * v[j].y) + (v[j].z * v[j].z + v[j].w * v[j].w); }
        const float rstd = 1.f / sqrtf(wave_sum(s2) * (1.f / DM) + 1e-5f);
        v2u* o = (v2u*)(XN + (size_t)m * DM) + lane;
#pragma unroll
        for (int j = 0; j < 4; ++j) { const f32x4 y = v[j] * rstd * gv[j] + bv[j]; xr[64 * j] = y; v2u w; w.x = pk2(y.x, y.y); w.y = pk2(y.z, y.w); o[64 * j] = w; }
    }
}

__device__ __forceinline__ float gelu_tanh(float v) {
    const float y = 0.7978845608f * (v + 0.044715f * v * v * v);
    const float e = ex2(y * 2.885390082f);
    const float th = 1.0f - 2.0f / (e + 1.0f);
    return 0.5f * v * (1.0f + th);
}
__device__ __forceinline__ void phase_conv(CP P, int layer, int r0, int gtid, int nthr) {
    const bf16* HF = (const bf16*)(P->ws + WS_HFF); bf16* HA = (bf16*)(P->ws + WS_HACT);
    const float* cw = P->cw + (size_t)layer * 3 * DFF; const float* cb = P->cb + (size_t)layer * DFF;
    constexpr int NCG = DFF / 8, NTB = FCH / 16;
    for (int it = gtid; it < NCG * NTB; it += nthr) {
        const int cgp = it % NCG, tb = it / NCG, c0 = 8 * cgp;
        const int ml = 16 * tb, m = r0 + ml;
        const int t0 = (m < MP) ? (m & (SP - 1)) : ((m - MP) & (SS - 1)); const int S = (m < MP) ? SP : SS;
        float w0[8], w1[8], w2[8], bb[8];
#pragma unroll
        for (int e = 0; e < 8; ++e) { w0[e] = cw[c0 + e]; w1[e] = cw[DFF + c0 + e]; w2[e] = cw[2 * DFF + c0 + e]; bb[e] = cb[c0 + e]; }
        const bf16* gp = HF + (size_t)ml * DFF2 + DFF + c0; const bf16* up = HF + (size_t)ml * DFF2 + c0; bf16* op = HA + (size_t)ml * DFF + c0;
        v4u prev = {0u, 0u, 0u, 0u}, cur, nxt;
        if (t0 > 0) prev = *(const v4u*)(gp - DFF2);
        cur = *(const v4u*)gp;
#pragma unroll 4
        for (int i = 0; i < 16; ++i) {
            if (t0 + i + 1 < S) nxt = *(const v4u*)(gp + (size_t)(i + 1) * DFF2); else nxt = (v4u){0u, 0u, 0u, 0u};
            const v4u uu = *(const v4u*)(up + (size_t)i * DFF2);
            const unsigned pw[4] = {prev.x, prev.y, prev.z, prev.w}, cwv[4] = {cur.x, cur.y, cur.z, cur.w}, nw[4] = {nxt.x, nxt.y, nxt.z, nxt.w}, uw[4] = {uu.x, uu.y, uu.z, uu.w};
            unsigned ow[4];
#pragma unroll
            for (int e2 = 0; e2 < 4; ++e2) {
                const float a0 = bflo(pw[e2]) * w0[2 * e2] + bflo(cwv[e2]) * w1[2 * e2] + bflo(nw[e2]) * w2[2 * e2] + bb[2 * e2];
                const float a1 = bfhi(pw[e2]) * w0[2 * e2 + 1] + bfhi(cwv[e2]) * w1[2 * e2 + 1] + bfhi(nw[e2]) * w2[2 * e2 + 1] + bb[2 * e2 + 1];
                ow[e2] = pk2(gelu_tanh(a0) * bflo(uw[e2]), gelu_tanh(a1) * bfhi(uw[e2]));
            }
            *(v4u*)(op + (size_t)i * DFF) = (v4u){ow[0], ow[1], ow[2], ow[3]};
            prev = cur; cur = nxt;
        }
    }
}
__device__ __forceinline__ void scan_unit(CP P, int R0, int S, int h, int dir, int vh, LAS unsigned char* lds, int tid, int wave, int lane) {
    const bf16* PQ = (const bf16*)(P->ws + WS_PL); const bf16* PZ = PQ + (size_t)(1 + dir) * PLANE; const bf16* PI = PQ + 3 * PLANE;
    bf16* OUT = (bf16*)P->out + (size_t)dir * PLANE;
    constexpr int QP = 136, KP = 72;
    LAS bf16* QT = (LAS bf16*)lds;
    LAS bf16* KK = QT + 64 * QP;
    LAS bf16* KHT = KK + 64 * QP;
    LAS bf16* VT = KHT + 128 * KP;
    LAS float* OB = (LAS float*)(VT + 64 * KP);
    LAS float* SEG = OB + 64 * 64;
    LAS float* DEC = SEG + 4 * 128;
    const int r32 = lane & 31, hi = lane >> 5;
    const int kb = wave >> 1, vb = wave & 1;
    const int k = tid & 127, seg = tid >> 7;
    const int vv = tid & 63, sg8 = tid >> 6;
    const float* lbt = dir ? P->lbb : P->lbf;
    const float t0_ = lbt[128 * h + k], t1_ = lbt[1024 + 128 * h + k];
    const float lb = 1.0f / (1.0f + __expf(t0_ - t1_));
    const int nc = S / 64;
    f32x16 St = {};
    const size_t colq = (size_t)128 * h + k, colv = (size_t)128 * h + 64 * vh + vv;
#pragma unroll 1
    for (int c = 0; c < nc; ++c) {
        float qv[16], kg[16], cs[16];
        float run = 0.f;
#pragma unroll
        for (int i = 0; i < 16; ++i) {
            const int tau = 64 * c + 16 * seg + i; const int row = R0 + (dir ? (S - 1 - tau) : tau);
            const float q = bf2f(PQ[(size_t)row * DM + colq]); const float z = bf2f(PZ[(size_t)row * DM + colq]);
            const float kk_ = (1.0f - lb) / (1.0f + __expf(z));
            const float lf2 = __log2f(1.0f - kk_);
            run += lf2; qv[i] = q; kg[i] = kk_; cs[i] = run;
        }
        unsigned vw[4];
#pragma unroll
        for (int i = 0; i < 4; ++i) {
            float a[2];
#pragma unroll
            for (int e = 0; e < 2; ++e) { const int tau = 64 * c + 8 * sg8 + 2 * i + e; const int row = R0 + (dir ? (S - 1 - tau) : tau);
                const float x = bf2f(PI[(size_t)row * DM + colv]); a[e] = x / (1.0f + __expf(-x)); }
            vw[i] = pk2(a[0], a[1]);
        }
        SEG[seg * 128 + k] = run;
        __syncthreads();
        {
            float pre = 0.f, tot = 0.f;
#pragma unroll
            for (int s = 0; s < 4; ++s) { const float v = SEG[s * 128 + k]; tot += v; if (s < seg) pre += v; }
            unsigned kh[8];
#pragma unroll
            for (int i = 0; i < 16; i += 2) {
                const float b0 = cs[i] + pre, b1 = cs[i + 1] + pre;
                QT[(16 * seg + i) * QP + k] = (bf16)f2bf(qv[i] * ex2(b0)); QT[(16 * seg + i + 1) * QP + k] = (bf16)f2bf(qv[i + 1] * ex2(b1));
                KK[(16 * seg + i) * QP + k] = (bf16)f2bf(kg[i] * ex2(-b0)); KK[(16 * seg + i + 1) * QP + k] = (bf16)f2bf(kg[i + 1] * ex2(-b1));
                kh[i >> 1] = pk2(kg[i] * ex2(tot - b0), kg[i + 1] * ex2(tot - b1));
            }
            *(LAS v4u*)(KHT + k * KP + 16 * seg) = (v4u){kh[0], kh[1], kh[2], kh[3]};
            *(LAS v4u*)(KHT + k * KP + 16 * seg + 8) = (v4u){kh[4], kh[5], kh[6], kh[7]};
            if (seg == 0) DEC[k] = ex2(tot);
            *(LAS v4u*)(VT + vv * KP + 8 * sg8) = (v4u){vw[0], vw[1], vw[2], vw[3]};
#pragma unroll
            for (int i = 0; i < 2; ++i) *(LAS f32x4*)(OB + (tid * 2 + i) * 4) = (f32x4){0.f, 0.f, 0.f, 0.f};
        }
        __syncthreads();
        {
            f32x16 op0 = {}, op1 = {};
#pragma unroll
            for (int s = 0; s < 2; ++s) {
                const bf16x8 sf = pack8(St, s);
                const int kof = 32 * kb + 16 * s + 4 * hi;
                const s16x4 a0l = *(const LAS s16x4*)(QT + r32 * QP + kof), a0h = *(const LAS s16x4*)(QT + r32 * QP + kof + 8);
                const s16x4 a1l = *(const LAS s16x4*)(QT + (32 + r32) * QP + kof), a1h = *(const LAS s16x4*)(QT + (32 + r32) * QP + kof + 8);
                op0 = MFMA32(__builtin_shufflevector(a0l, a0h, 0, 1, 2, 3, 4, 5, 6, 7), sf, op0);
                op1 = MFMA32(__builtin_shufflevector(a1l, a1h, 0, 1, 2, 3, 4, 5, 6, 7), sf, op1);
            }
            const int tbi = kb & 1, sbi = kb >> 1;
            if (sbi <= tbi) {
                f32x16 pt = {};
#pragma unroll
                for (int kk = 0; kk < 8; ++kk) {
                    const bf16x8 a = *(const LAS bf16x8*)(KK + (32 * sbi + r32) * QP + 16 * kk + 8 * hi);
                    const bf16x8 b = *(const LAS bf16x8*)(QT + (32 * tbi + r32) * QP + 16 * kk + 8 * hi);
                    pt = MFMA32(a, b, pt);
                }
                if (sbi == tbi) {
#pragma unroll
                    for (int r = 0; r < 16; ++r) if (crow(r, hi) > r32) pt[r] = 0.f;
                }
                f32x16 oi = {};
#pragma unroll
                for (int s = 0; s < 2; ++s) {
                    const bf16x8 pa = pack8(pt, s);
                    const int sof = 32 * sbi + 16 * s + 4 * hi;
                    const s16x4 bl = *(const LAS s16x4*)(VT + (32 * vb + r32) * KP + sof), bh = *(const LAS s16x4*)(VT + (32 * vb + r32) * KP + sof + 8);
                    oi = MFMA32(pa, __builtin_shufflevector(bl, bh, 0, 1, 2, 3, 4, 5, 6, 7), oi);
                }
                if (tbi == 0) op0 += oi; else op1 += oi;
            }
#pragma unroll
            for (int r = 0; r < 16; ++r) {
                const int t = crow(r, hi);
                __hip_atomic_fetch_add(OB + t * 64 + 32 * vb + r32, op0[r], __ATOMIC_RELAXED, __HIP_MEMORY_SCOPE_WORKGROUP);
                __hip_atomic_fetch_add(OB + (32 + t) * 64 + 32 * vb + r32, op1[r], __ATOMIC_RELAXED, __HIP_MEMORY_SCOPE_WORKGROUP);
            }
#pragma unroll
            for (int r = 0; r < 16; ++r) St[r] *= DEC[32 * kb + crow(r, hi)];
#pragma unroll
            for (int s = 0; s < 4; ++s) {
                const bf16x8 a = *(const LAS bf16x8*)(KHT + (32 * kb + r32) * KP + 16 * s + 8 * hi);
                const bf16x8 b = *(const LAS bf16x8*)(VT + (32 * vb + r32) * KP + 16 * s + 8 * hi);
                St = MFMA32(a, b, St);
            }
        }
        __syncthreads();
        {
            const int t = tid >> 3, v0 = 8 * (tid & 7);
            const int tau = 64 * c + t; const int row = R0 + (dir ? (S - 1 - tau) : tau);
            const f32x4 a = *(const LAS f32x4*)(OB + t * 64 + v0), b = *(const LAS f32x4*)(OB + t * 64 + v0 + 4);
            v4u w; w.x = pk2(a.x, a.y); w.y = pk2(a.z, a.w); w.z = pk2(b.x, b.y); w.w = pk2(b.z, b.w);
            *(v4u*)(OUT + (size_t)row * DM + 128 * h + 64 * vh + v0) = w;
        }
    }
    __syncthreads();
}

__device__ __forceinline__ void phase_combine(CP P, int gw, int NGW, int lane) {
    const bf16* OF = (const bf16*)P->out; const bf16* OBW = OF + PLANE;
    bf16* PQ = (bf16*)(P->ws + WS_PL); const bf16* PG = PQ + 4 * PLANE;
    float gnv[16];
#pragma unroll
    for (int e = 0; e < 16; ++e) gnv[e] = P->gn[16 * lane + e];
    for (int m = gw; m < MT; m += NGW) {
        const size_t off = (size_t)m * DM + 16 * lane;
        const v4u f0 = *(const v4u*)(OF + off), f1 = *(const v4u*)(OF + off + 8), b0 = *(const v4u*)(OBW + off), b1 = *(const v4u*)(OBW + off + 8);
        const v4u g0 = *(const v4u*)(PG + off), g1 = *(const v4u*)(PG + off + 8);
        const unsigned fw[8] = {f0.x, f0.y, f0.z, f0.w, f1.x, f1.y, f1.z, f1.w}, bw[8] = {b0.x, b0.y, b0.z, b0.w, b1.x, b1.y, b1.z, b1.w}, gw_[8] = {g0.x, g0.y, g0.z, g0.w, g1.x, g1.y, g1.z, g1.w};
        float o[16]; float ss = 0.f;
#pragma unroll
        for (int e = 0; e < 8; ++e) { o[2 * e] = bflo(fw[e]) + bflo(bw[e]); o[2 * e + 1] = bfhi(fw[e]) + bfhi(bw[e]); ss += o[2 * e] * o[2 * e] + o[2 * e + 1] * o[2 * e + 1]; }
        ss += __shfl_xor(ss, 1); ss += __shfl_xor(ss, 2); ss += __shfl_xor(ss, 4);
        const float r = 1.0f / sqrtf(ss * (1.0f / 128.0f) + 1e-6f);
        unsigned ow[8];
#pragma unroll
        for (int e = 0; e < 8; ++e) {
            const float ga = bflo(gw_[e]), gb = bfhi(gw_[e]);
            const float ya = o[2 * e] * r * gnv[2 * e] * (ga / (1.0f + __expf(-ga))), yb = o[2 * e + 1] * r * gnv[2 * e + 1] * (gb / (1.0f + __expf(-gb)));
            ow[e] = pk2(ya, yb);
        }
        *(v4u*)(PQ + off) = (v4u){ow[0], ow[1], ow[2], ow[3]}; *(v4u*)(PQ + off + 8) = (v4u){ow[4], ow[5], ow[6], ow[7]};
    }
}

#ifndef PHM
#define PHM 0xffff
#endif
#define IDS() CP P = FRESH_P(); int tid = threadIdx.x; asm volatile("" : "+v"(tid)); const int lane = tid & 63, wave = __builtin_amdgcn_readfirstlane(tid >> 6); \
    int bid = blockIdx.x; asm volatile("" : "+s"(bid)); const int G = gridDim.x; const int vcu = (G % 8 == 0) ? (bid % 8) * (G / 8) + bid / 8 : bid; \
    const int gw = vcu * NWAVES + wave, NGW = G * NWAVES; const int gtid = bid * NTHREADS + tid, nthr = G * NTHREADS; unsigned char* ws = P->ws; bf16* XN = (bf16*)(ws + WS_XN); \
    (void)lane; (void)gw; (void)NGW; (void)gtid; (void)nthr; (void)XN; (void)vcu;
__global__ void __launch_bounds__(NTHREADS, 2) fwd_megakernel(Params Pin) {
    extern __shared__ __attribute__((aligned(16))) unsigned char lds_raw[];
    LAS unsigned char* lds = (LAS unsigned char*)lds_raw;
    cg::grid_group grid = cg::this_grid();
    typedef pg8::EpiBf16<0> EB;

    if (PHM & 1) { IDS(); phase_prologue(P, lds, gw, NGW, lane, wave); }
    grid.sync();
#pragma unroll 1
    for (int layer = 0; layer < 2; ++layer) {
        if (layer == 0) {
            if (PHM & 2) { IDS(); pg8::Gemm g{XN, (const bf16*)(ws + WS_W_INAB), MT, ABIN, DM}; pg8::StaticOrder S; S.init(MT, ABIN, G, bid);
              EB E{(bf16*)(ws + WS_HAB), ABIN, nullptr, 0, 0, 1.f};
              pg8::gemm_phase<EB, pg8::StaticOrder, PG8_ALIGN, PG8_SP2>(lds, g, S, E); }
            grid.sync();
            if (PHM & 4) { IDS(); phase_prep(P, gw, NGW, lane); }
            grid.sync();
            if (PHM & 8) { IDS();
                const bf16* H = (const bf16*)(ws + WS_HAB); bf16* Y = (bf16*)(ws + WS_YAT);
                for (int U = vcu; U < 2048; U += G) {
                    const int x = (U & 255) >> 5, j = U & 31, i = U >> 8, u = i * 32 + j, grp = u >> 7, rem = u & 127, h = grp * 4 + (rem >> 5), qb = rem & 31;
                    const size_t rb = (size_t)MP + (size_t)x * SS;
                    attn_body::attn_unit<8, SS / 64>(qb, (const attn_body::bf16*)(H + rb * ABIN + 1536 + 64 * h), (const attn_body::bf16*)(H + rb * ABIN + 2048 + 64 * grp),
                                            (const attn_body::bf16*)(H + rb * ABIN + 2176 + 64 * grp), (attn_body::bf16*)(Y + rb * DM + 512 + 64 * h), (char*)lds_raw);
                }
            }
            if (PHM & 8) { IDS();
                const bf16* H = (const bf16*)(ws + WS_HAB); bf16* Y = (bf16*)(ws + WS_YAT);
                for (int U = vcu; U < 512; U += G) {
                    const int x = (U & 255) >> 5, j = U & 31, i = U >> 8, u = i * 32 + j, h = u >> 3, qb = u & 7, grp = h >> 2;
                    const size_t rb = (size_t)x * SP;
                    attn_body::attn_unit<8, SP / 64>(qb, (const attn_body::bf16*)(H + rb * ABIN + 1536 + 64 * h), (const attn_body::bf16*)(H + rb * ABIN + 2048 + 64 * grp),
                                            (const attn_body::bf16*)(H + rb * ABIN + 2176 + 64 * grp), (attn_body::bf16*)(Y + rb * DM + 512 + 64 * h), (char*)lds_raw);
                }
            }
            __syncthreads();
            if (PHM & 16) { IDS();
                const bf16* H = (const bf16*)(ws + WS_HAB); bf16* Y = (bf16*)(ws + WS_YAT);
                for (int U = vcu; U < 1024; U += G) {
                    const int x = (U & 255) >> 5, j = U & 31, i = U >> 8, u = i * 32 + j, h = u >> 4, sp = u & 15;
                    dilated_unit(H, Y, MP + x * SS, SS, h, sp, lds, tid, wave, lane);
                }
                for (int U = vcu; U < 256; U += G) {
                    const int x = (U & 255) >> 5, j = U & 31, h = j >> 2, sp = j & 3;
                    dilated_unit(H, Y, x * SP, SP, h, sp, lds, tid, wave, lane);
                }
            }
            grid.sync();
            if (PHM & 32) { IDS(); pg8::Gemm g{(const bf16*)(ws + WS_YAT), (const bf16*)(ws + WS_W_OUTAB), MT, DM, DM}; pg8::StaticOrder S; S.init(MT, DM, G, bid);
              EpiRes<0> E{P->xp, P->xs, MP, nullptr, P->out};
              pg8::gemm_phase<EpiRes<0>, pg8::StaticOrder, PG8_ALIGN, PG8_SP2>(lds, g, S, E); }
            grid.sync();
        } else {
            if (PHM & 64) { IDS(); pg8::Gemm g{XN, (const bf16*)(ws + WS_W_INC), MT, CIN, DM}; pg8::StaticOrder S; S.init(MT, CIN, G, bid);
              EB E{(bf16*)(ws + WS_PL), DM, nullptr, DM, PLANE, 1.f};
              pg8::gemm_phase<EB, pg8::StaticOrder, PG8_ALIGN, PG8_SP2>(lds, g, S, E); }
            grid.sync();
            if (PHM & 128) { IDS();
              for (int U = vcu; U < 512; U += G) {
                const int lng = U < 256, u = U & 255, x = u >> 5, rem = u & 31, h = rem >> 2, dir = (rem >> 1) & 1, vh = rem & 1;
                scan_unit(P, lng ? MP + x * SS : x * SP, lng ? SS : SP, h, dir, vh, lds, tid, wave, lane);
              } }
            grid.sync();
            if (PHM & 256) { IDS(); phase_combine(P, gw, NGW, lane); }
            grid.sync();
            if (PHM & 512) { IDS(); pg8::Gemm g{(const bf16*)(ws + WS_PL), (const bf16*)(ws + WS_W_OUTC), MT, DM, DM}; pg8::StaticOrder S; S.init(MT, DM, G, bid);
              EpiRes<1> E{nullptr, nullptr, 0, XN, P->out};
              pg8::gemm_phase<EpiRes<1>, pg8::StaticOrder, PG8_ALIGN, PG8_SP2>(lds, g, S, E); }
            grid.sync();
        }
        if (PHM & 1024) { IDS(); phase_ln(P->out, XN, P->lnmg + layer * DM, P->lnmb + layer * DM, gw, NGW, lane); }
        grid.sync();
#pragma unroll 1
        for (int ch = 0; ch < 2; ++ch) {
            const int r0 = ch * FCH;
            if (PHM & 2048) { IDS(); pg8::Gemm g{XN + (size_t)r0 * DM, (const bf16*)(ws + WS_W_UP) + (size_t)layer * DFF2 * DM, FCH, DFF2, DM}; pg8::StaticOrder S; S.init(FCH, DFF2, G, bid);
              EB E{(bf16*)(ws + WS_HFF), DFF2, nullptr, 0, 0, 1.f};
              pg8::gemm_phase<EB, pg8::StaticOrder, PG8_ALIGN, PG8_SP2>(lds, g, S, E); }
            grid.sync();
            if (PHM & 4096) { IDS(); phase_conv(P, layer, r0, gtid, nthr); }
            grid.sync();
            if (PHM & 8192) { IDS(); pg8::Gemm g{(const bf16*)(ws + WS_HACT), (const bf16*)(ws + WS_W_DN) + (size_t)layer * DM * DFF, FCH, DM, DFF}; pg8::StaticOrder S; S.init(FCH, DM, G, bid);
              float* o = P->out + (size_t)r0 * DM;
              EpiRes<0> E{o, o, 1 << 30, nullptr, o};
              pg8::gemm_phase<EpiRes<0>, pg8::StaticOrder, PG8_ALIGN, PG8_SP2>(lds, g, S, E); }
            grid.sync();
        }
        if (PHM & 16384) { IDS(); phase_ln(P->out, XN, P->lnfg + layer * DM, P->lnfb + layer * DM, gw, NGW, lane); }
        if (layer == 0) grid.sync();
    }
}

extern "C" void kernel_launch(void* const* d_in, const int* in_sizes, int n_in, void* d_out, int out_size, void* d_ws, size_t ws_size, hipStream_t stream) {
    static int grid = 0;
    if (grid == 0) {
        if (n_in != 19 || out_size != MT * DM || ws_size < WS_NEED) { fprintf(stderr, "kernel_launch: unexpected shapes: n_in %d out %d ws %zu (need %zu)\n", n_in, out_size, ws_size, (size_t)WS_NEED); grid = -1; return; }
        int dev = 0, cus = 0, per_cu = 0;
        hipGetDevice(&dev); hipDeviceGetAttribute(&cus, hipDeviceAttributeMultiprocessorCount, dev);
        if (hipFuncSetAttribute((const void*)fwd_megakernel, hipFuncAttributeMaxDynamicSharedMemorySize, LDS_BYTES) != hipSuccess) { fprintf(stderr, "kernel_launch: hipFuncSetAttribute failed\n"); grid = -1; return; }
        if (hipOccupancyMaxActiveBlocksPerMultiprocessor(&per_cu, (const void*)fwd_megakernel, NTHREADS, LDS_BYTES) != hipSuccess || per_cu < 1) { fprintf(stderr, "kernel_launch: occupancy query gives %d\n", per_cu); per_cu = 1; }
        (void)hipGetLastError();
        grid = cus * 1;
    }
    if (grid < 0) return;
    Params p{};
    const float** pp = (const float**)&p;
    for (int i = 0; i < 19; ++i) pp[i] = (const float*)d_in[i];
    p.out = (float*)d_out; p.ws = (unsigned char*)d_ws;
    for (int i = 0; i < 8; ++i) p.fa[i] = (float)(pow(500000.0, -(double)i / 8.0) / 6.283185307179586476925);
    for (int i = 0; i < 16; ++i) p.fb[i] = (float)(pow(10000.0, -(double)i / 16.0) / 6.283185307179586476925);
    void* args[] = {&p};
    hipError_t e = hipLaunchCooperativeKernel((const void*)fwd_megakernel, dim3(grid), dim3(NTHREADS), args, LDS_BYTES, stream);
    if (e != hipSuccess) fprintf(stderr, "cooperative launch failed: %s (grid %d)\n", hipGetErrorString(e), grid);
}
```

```cpp
#include <hip/hip_runtime.h>
#include <hip/hip_cooperative_groups.h>
#include <cstdio>
#include <cstdint>
namespace pg8 {
#define PG8_LAS __attribute__((address_space(3)))
typedef unsigned short bf16_t;
typedef short bf16x8 __attribute__((ext_vector_type(8)));
typedef float f32x4 __attribute__((ext_vector_type(4)));
typedef unsigned u32x4 __attribute__((ext_vector_type(4)));
constexpr int BM = 256, BK = 64, HALF = 128, HTB = HALF * BK * 2  , STAGE_BYTES = 8 * HTB, NXCD = 8, WGM = 8;

__host__ __device__ __forceinline__ int lds_byte(int r, int c) { const int st = (r >> 4) * 2 + (c >> 5), rr = r & 15, cc = c & 31, ob = rr * 64 + cc * 2; return st * 1024 + (ob ^ (((ob >> 9) & 1) << 5)); }
__host__ __device__ __forceinline__ void stage_rc(int b, int& R, int& C) { const int st = b / 1024, sb = b % 1024, swz = sb ^ (((sb >> 9) & 1) << 5); R = (st >> 1) * 16 + swz / 64; C = (st & 1) * 32 + (swz % 64) / 2; }
__host__ __device__ __forceinline__ int perm32(int rho) { const int n = rho >> 4, i = rho & 15; return 8 * (i >> 2) + 4 * n + (i & 3); }

struct Unit { int pm, pn; };
struct Gemm { const bf16_t* A; const bf16_t* Bt; int M, N, K; };

struct StaticOrder {
    int nM, nN, nwg, G, c;
    __host__ __device__ void init(int M, int N, int G_, int c_) { nM = M / BM; nN = N / BM; nwg = nM * nN; G = G_; c = c_; }
    __host__ __device__ bool next(int i, Unit& u) const {
        const long L = (long)i * G + c; if (L >= nwg) return false;
        int wgid = (int)L; { const int q = nwg / NXCD, r = nwg % NXCD, xcd = wgid % NXCD, off = wgid / NXCD; wgid = (xcd < r ? xcd * (q + 1) : r * (q + 1) + (xcd - r) * q) + off; }
        const int nig = WGM * nN, gid = wgid / nig, fm = gid * WGM, gsz = (nM - fm) < WGM ? (nM - fm) : WGM;
        u.pm = fm + ((wgid % nig) % gsz); u.pn = (wgid % nig) / gsz; return true;
    }
    __device__ __forceinline__ void a_ready(const Unit&) const {}
    __device__ __forceinline__ void done(const Unit&) const {}
};

__device__ __forceinline__ unsigned cvt_pk_bf16(float lo, float hi) { unsigned r; asm volatile("v_cvt_pk_bf16_f32 %0, %1, %2" : "=v"(r) : "v"(lo), "v"(hi)); return r; }
typedef float f32x2 __attribute__((ext_vector_type(2)));
__device__ __forceinline__ f32x2 gelu_pk(f32x2 v) {
    const f32x2 av = __builtin_elementwise_abs(v), d = av * 0.2316418882f + 1.0f;
    f32x2 t; t.x = __builtin_amdgcn_rcpf(d.x); t.y = __builtin_amdgcn_rcpf(d.y);
    f32x2 q = t * 0.5307027145f + (-0.7265760135f); q = q * t + 0.7107068705f; q = q * t + (-0.142248368f); q = q * t + 0.127414796f; q = q * t;
    const f32x2 s = (v * v) * (-0.72134752044f);
    f32x2 e; e.x = __builtin_amdgcn_exp2f(s.x); e.y = __builtin_amdgcn_exp2f(s.y);
    const f32x2 m = v * (q * e), r = v - m;
    f32x2 o; o.x = v.x < 0.f ? m.x : r.x; o.y = v.y < 0.f ? m.y : r.y; return o;
}

template <int ACT  > struct EpiBf16 {
    static constexpr bool PERM = true, AFTER_DRAIN = false; static_assert(ACT == 0 || ACT == 1, "EpiBf16: ACT is 0 (none) or 1 (gelu_pk)");
    bf16_t* O; int ldc; const float* bias; int split_cols; size_t split_stride; float scale0;
    __device__ __forceinline__ void operator()(const f32x4 (&acc)[2][2][4][2], const Unit& u, int wr, int wc, int fr, int fq) const {
        const int row0 = u.pm * BM + wr * 64 + fr; int colt = u.pn * BM; bf16_t* base = O;
        float sc = 1.f; if (split_cols) { const int t = colt / split_cols; base += (size_t)t * split_stride; colt -= t * split_cols; if (t == 0) sc = scale0; }
        const int col0 = colt + wc * 32 + 8 * fq, bcol0 = u.pn * BM + wc * 32 + 8 * fq;
        f32x4 bv[2][2];
#pragma unroll
        for (int bj = 0; bj < 2; ++bj)
#pragma unroll
            for (int n = 0; n < 2; ++n) bv[bj][n] = bias ? *(const f32x4*)(bias + bcol0 + bj * HALF + 4 * n) : (f32x4){0.f, 0.f, 0.f, 0.f};
#pragma unroll
        for (int ai = 0; ai < 2; ++ai)
#pragma unroll
            for (int m = 0; m < 4; ++m) { bf16_t* rowp = base + (size_t)(row0 + ai * HALF + m * 16) * ldc + col0;
#pragma unroll
                for (int bj = 0; bj < 2; ++bj) { f32x4 v0 = acc[ai][bj][m][0] + bv[bj][0], v1 = acc[ai][bj][m][1] + bv[bj][1];
                    if (ACT == 1) { f32x2 a = gelu_pk((f32x2){v0[0], v0[1]}), b = gelu_pk((f32x2){v0[2], v0[3]}), c = gelu_pk((f32x2){v1[0], v1[1]}), d = gelu_pk((f32x2){v1[2], v1[3]});
                        v0 = (f32x4){a.x, a.y, b.x, b.y}; v1 = (f32x4){c.x, c.y, d.x, d.y}; }
                    v0 = v0 * sc; v1 = v1 * sc; u32x4 w; w.x = cvt_pk_bf16(v0[0], v0[1]); w.y = cvt_pk_bf16(v0[2], v0[3]); w.z = cvt_pk_bf16(v1[0], v1[1]); w.w = cvt_pk_bf16(v1[2], v1[3]);
                    *(u32x4*)(rowp + bj * HALF) = w; } }
    }
};

struct PanelStats {
    unsigned* xbuf;
    unsigned* cnt;
    unsigned* tmo;
    int ntn; float eps;
    unsigned code;
    __device__ __forceinline__ bool run(const f32x4 (&v)[2][2][4][2], const Unit& u, int wr, int wc, int fr, int fq, PG8_LAS unsigned char* lds, int wid, int lane) const {
        typedef float f32x2v __attribute__((ext_vector_type(2)));
        PG8_LAS f32x2v* P = (PG8_LAS f32x2v*)lds;
        PG8_LAS f32x2v* S = (PG8_LAS f32x2v*)(lds + 8192);
        PG8_LAS unsigned* flag = (PG8_LAS unsigned*)(lds + 8192 + 2048);
#pragma unroll
        for (int ai = 0; ai < 2; ++ai)
#pragma unroll
            for (int m = 0; m < 4; ++m) {
                float s = 0.f;
#pragma unroll
                for (int bj = 0; bj < 2; ++bj)
#pragma unroll
                    for (int n = 0; n < 2; ++n) { const f32x4 x = v[ai][bj][m][n]; s += (x[0] + x[1]) + (x[2] + x[3]); }
                s += __shfl_xor(s, 16); s += __shfl_xor(s, 32);
                const float mw = s * (1.0f / 64.0f); float q = 0.f;
#pragma unroll
                for (int bj = 0; bj < 2; ++bj)
#pragma unroll
                    for (int n = 0; n < 2; ++n) { const f32x4 d = v[ai][bj][m][n] - mw; q += (d[0] * d[0] + d[1] * d[1]) + (d[2] * d[2] + d[3] * d[3]); }
                q += __shfl_xor(q, 16); q += __shfl_xor(q, 32);
                if (fq == 0) P[(ai * HALF + wr * 64 + m * 16 + fr) * 4 + wc] = (f32x2v){mw, q};
            }
        asm volatile("s_waitcnt lgkmcnt(0)" ::: "memory"); __builtin_amdgcn_s_barrier(); asm volatile("" ::: "memory");
#if defined(BROKEN_EXCHANGE_NO_WAIT)
#warning BROKEN CONTROL BUILD: the row-statistics exchange does not wait; results are wrong by design
        if (blockIdx.x >= 64) { const long long t0_ = clock64(); while (clock64() - t0_ < 60000) __builtin_amdgcn_s_sleep(8); }
#endif
        const int row = wid * 32 + (lane & 31);
        if (lane < 32) {
            const f32x2v a = P[row * 4 + 0], b = P[row * 4 + 1], c = P[row * 4 + 2], d = P[row * 4 + 3];
            const float mt = (a.x + b.x + c.x + d.x) * 0.25f;
            const float da = a.x - mt, db = b.x - mt, dc = c.x - mt, dd = d.x - mt;
            const float m2 = (a.y + b.y) + (c.y + d.y) + 64.0f * ((da * da + db * db) + (dc * dc + dd * dd));
            unsigned long long* slot = (unsigned long long*)xbuf + ((size_t)(u.pm * BM + row) * 4 + u.pn);
            __hip_atomic_store(slot, ((unsigned long long)__float_as_uint(m2) << 32) | __float_as_uint(mt), __ATOMIC_RELAXED, __HIP_MEMORY_SCOPE_AGENT);
        }
        asm volatile("s_waitcnt vmcnt(0)" ::: "memory");
        if (lane == 0) __hip_atomic_fetch_add(cnt + 64 * u.pm, 1u, __ATOMIC_RELAXED, __HIP_MEMORY_SCOPE_AGENT);
        if (wid == 0) {
            bool dead = false; const unsigned long long t0 = __builtin_amdgcn_s_memrealtime(); const unsigned want = 8u * (unsigned)ntn;
            for (;;) {
#if defined(BROKEN_EXCHANGE_NO_WAIT)
                break;
#endif
                if ((unsigned)__builtin_amdgcn_readfirstlane(__hip_atomic_load(cnt + 64 * u.pm, __ATOMIC_RELAXED, __HIP_MEMORY_SCOPE_AGENT)) >= want) break;
                if (__builtin_amdgcn_s_memrealtime() - t0 > 2000000ull) {
                    if (lane == 0) { unsigned expect = 0u; __hip_atomic_compare_exchange_strong(tmo + 1, &expect, code | (unsigned)(u.pm & 0xff), __ATOMIC_RELAXED, __ATOMIC_RELAXED, __HIP_MEMORY_SCOPE_AGENT);
                                     __hip_atomic_store(tmo, 1u, __ATOMIC_RELAXED, __HIP_MEMORY_SCOPE_AGENT); }
                    dead = true; break; }
                __builtin_amdgcn_s_sleep(2);
            }
            __builtin_amdgcn_fence(__ATOMIC_ACQUIRE, "agent");
            if (lane == 0) flag[0] = dead ? 1u : 0u;
        }
        asm volatile("s_waitcnt vmcnt(0) lgkmcnt(0)" ::: "memory"); __builtin_amdgcn_s_barrier(); asm volatile("" ::: "memory");
        const bool bad = flag[0] != 0u;
        if (lane < 32) {
            const unsigned long long* slot = (const unsigned long long*)xbuf + (size_t)(u.pm * BM + row) * 4; float mt[4], m2[4]; float ms = 0.f;
#pragma unroll
            for (int t = 0; t < 4; ++t) { if (t < ntn) { const unsigned long long w = __hip_atomic_load(slot + t, __ATOMIC_RELAXED, __HIP_MEMORY_SCOPE_AGENT); mt[t] = __uint_as_float((unsigned)w); m2[t] = __uint_as_float((unsigned)(w >> 32)); } else { mt[t] = 0.f; m2[t] = 0.f; } ms += mt[t]; }
            const float mean = ms / (float)ntn; float q = 0.f;
#pragma unroll
            for (int t = 0; t < 4; ++t) if (t < ntn) { const float dm = mt[t] - mean; q += m2[t] + 256.0f * dm * dm; }
            S[row] = (f32x2v){mean, 1.0f / sqrtf(q / (256.0f * (float)ntn) + eps)};
        }
        asm volatile("s_waitcnt lgkmcnt(0)" ::: "memory"); __builtin_amdgcn_s_barrier(); asm volatile("" ::: "memory");
        return bad;
    }
};
struct EpiLnRes {
    static constexpr bool PERM = false, AFTER_DRAIN = true;
    const float* base; float* out; int ldc; const float* bias; PanelStats st; unsigned poison;
    __device__ __forceinline__ void fused(f32x4 (&acc)[2][2][4][2], const Unit& u, int wr, int wc, int fr, int fq, PG8_LAS unsigned char* lds, int wid, int lane) const {
        typedef float f32x2v __attribute__((ext_vector_type(2)));
        const PG8_LAS f32x2v* S = (const PG8_LAS f32x2v*)(lds + 8192);
        const int col0 = u.pn * BM + wc * 32 + 4 * fq;
#pragma unroll
        for (int bj = 0; bj < 2; ++bj)
#pragma unroll
            for (int n = 0; n < 2; ++n) { const f32x4 bv = bias ? *(const f32x4*)(bias + col0 + bj * HALF + n * 16) : (f32x4){0.f, 0.f, 0.f, 0.f};
#pragma unroll
                for (int ai = 0; ai < 2; ++ai)
#pragma unroll
                    for (int m = 0; m < 4; ++m) acc[ai][bj][m][n] += bv; }
        f32x4 pre[4][2][2];
#pragma unroll
        for (int m = 0; m < 4; ++m) { const size_t off = (size_t)(u.pm * BM + wr * 64 + m * 16 + fr) * ldc + col0;
#pragma unroll
            for (int bj = 0; bj < 2; ++bj)
#pragma unroll
                for (int n = 0; n < 2; ++n) pre[m][bj][n] = *(const f32x4*)(base + off + bj * HALF + n * 16); }
        const bool bad = st.run(acc, u, wr, wc, fr, fq, lds, wid, lane) || poison != 0u;
        const float qnan = __builtin_nanf("");
#pragma unroll
        for (int ai = 0; ai < 2; ++ai)
#pragma unroll
            for (int m = 0; m < 4; ++m) { const int r = ai * HALF + wr * 64 + m * 16 + fr; const f32x2v sr = S[r]; const size_t off = (size_t)(u.pm * BM + r) * ldc + col0;
#pragma unroll
                for (int bj = 0; bj < 2; ++bj)
#pragma unroll
                    for (int n = 0; n < 2; ++n) { const f32x4 bs = ai == 0 ? pre[m][bj][n] : *(const f32x4*)(base + off + bj * HALF + n * 16); f32x4 o = bs + (acc[ai][bj][m][n] - sr.x) * sr.y;
                        if (bad) o = (f32x4){qnan, qnan, qnan, qnan}; *(f32x4*)(out + off + bj * HALF + n * 16) = o; }
                if (m & 1) asm volatile("" ::: "memory"); }
    }
};
struct EpiLnResLn {
    static constexpr bool PERM = false, AFTER_DRAIN = true;
    const float* base; float* out; bf16_t* xn; int ldc; const float* bias; PanelStats st1, st2; unsigned poison;
    __device__ __forceinline__ void fused(f32x4 (&acc)[2][2][4][2], const Unit& u, int wr, int wc, int fr, int fq, PG8_LAS unsigned char* lds, int wid, int lane) const {
        typedef float f32x2v __attribute__((ext_vector_type(2))); typedef unsigned u32x2v __attribute__((ext_vector_type(2)));
        const PG8_LAS f32x2v* S = (const PG8_LAS f32x2v*)(lds + 8192);
        const int col0 = u.pn * BM + wc * 32 + 4 * fq;
#pragma unroll
        for (int bj = 0; bj < 2; ++bj)
#pragma unroll
            for (int n = 0; n < 2; ++n) { const f32x4 bv = bias ? *(const f32x4*)(bias + col0 + bj * HALF + n * 16) : (f32x4){0.f, 0.f, 0.f, 0.f};
#pragma unroll
                for (int ai = 0; ai < 2; ++ai)
#pragma unroll
                    for (int m = 0; m < 4; ++m) acc[ai][bj][m][n] += bv; }
        bool bad = st1.run(acc, u, wr, wc, fr, fq, lds, wid, lane) || poison != 0u;
        const float qnan = __builtin_nanf("");
#pragma unroll
        for (int ai = 0; ai < 2; ++ai)
#pragma unroll
            for (int m = 0; m < 4; ++m) { const int r = ai * HALF + wr * 64 + m * 16 + fr; const f32x2v sr = S[r]; const size_t off = (size_t)(u.pm * BM + r) * ldc + col0;
#pragma unroll
                for (int bj = 0; bj < 2; ++bj)
#pragma unroll
                    for (int n = 0; n < 2; ++n) { const f32x4 bs = *(const f32x4*)(base + off + bj * HALF + n * 16); acc[ai][bj][m][n] = bs + (acc[ai][bj][m][n] - sr.x) * sr.y; }
                asm volatile("" : "+v"(acc[ai][0][m][0]), "+v"(acc[ai][0][m][1]), "+v"(acc[ai][1][m][0]), "+v"(acc[ai][1][m][1]));
                if (m & 1) asm volatile("" ::: "memory"); }
        const bool bad1 = bad;
        bad = st2.run(acc, u, wr, wc, fr, fq, lds, wid, lane) || bad;
#pragma unroll
        for (int ai = 0; ai < 2; ++ai)
#pragma unroll
            for (int m = 0; m < 4; ++m) { const int r = ai * HALF + wr * 64 + m * 16 + fr; const f32x2v sr = S[r]; const size_t off = (size_t)(u.pm * BM + r) * ldc + col0;
#pragma unroll
                for (int bj = 0; bj < 2; ++bj)
#pragma unroll
                    for (int n = 0; n < 2; ++n) { const f32x4 x1 = acc[ai][bj][m][n]; *(f32x4*)(out + off + bj * HALF + n * 16) = bad1 ? (f32x4){qnan, qnan, qnan, qnan} : x1;
                        const f32x4 o = (x1 - sr.x) * sr.y; u32x2v w; w.x = cvt_pk_bf16(o[0], o[1]); w.y = cvt_pk_bf16(o[2], o[3]);
                        if (bad) { w.x = 0x7fc07fc0u; w.y = 0x7fc07fc0u; } *(u32x2v*)(xn + off + bj * HALF + n * 16) = w; }
                asm volatile("" ::: "memory"); }
    }
};

template <class Epi, class Sched, bool ALIGN_EPI = false, bool SP2 = false>
__device__ __forceinline__ void gemm_phase(PG8_LAS unsigned char* lds, const Gemm g, const Sched& S, const Epi& E) {
    int tid_ = threadIdx.x; asm volatile("" : "+v"(tid_));
    const int tid = tid_, wid = __builtin_amdgcn_readfirstlane(tid >> 6), lane = tid & 63, wr = wid >> 2, wc = wid & 3, fr = lane & 15, fq = lane >> 4;
    const int K = g.K, nt = K / BK;
    unsigned voffA[2], voffB[2];
#pragma unroll
    for (int i = 0; i < 2; ++i) { int R, C; stage_rc(tid * 16 + i * 8192, R, C); const int Rb = Epi::PERM ? ((R & ~31) + perm32(R & 31)) : R;
        voffA[i] = (unsigned)(R * K + C) * 2u; voffB[i] = (unsigned)(Rb * K + C) * 2u; }
    const size_t kstep = (size_t)(BK * 2);
    const size_t hstep = (size_t)HALF * K * 2;
    const size_t tstep = 2 * hstep;
    const unsigned ldsw = (unsigned)wid * 1024u;
    const int aoff = lds_byte(wr * 64 + fr, fq * 8), boff = lds_byte(wc * 32 + fr, fq * 8);
#define PG8_SA(b, h) (((b) * 2 + (h)) * HTB)
#define PG8_SB(b, h) ((4 + (b) * 2 + (h)) * HTB)
#define PG8_STAGE(bufoff, gbase, voff) do { _Pragma("unroll") for (int _i = 0; _i < 2; ++_i) \
        __builtin_amdgcn_global_load_lds((const unsigned*)((const char*)(gbase) + (voff)[_i]), (PG8_LAS unsigned*)(lds + (bufoff) + ldsw + _i * 8192), 16, 0, 0); } while (0)
#define PG8_LDA(dst, b, h) do { _Pragma("unroll") for (int m = 0; m < 4; ++m) _Pragma("unroll") for (int k = 0; k < 2; ++k) dst[m][k] = *(const PG8_LAS bf16x8*)(lds + PG8_SA(b, h) + aoff + m * 2048 + k * 1024); } while (0)
#define PG8_LDB(dst, b, h) do { _Pragma("unroll") for (int n = 0; n < 2; ++n) _Pragma("unroll") for (int k = 0; k < 2; ++k) dst[n][k] = *(const PG8_LAS bf16x8*)(lds + PG8_SB(b, h) + boff + n * 2048 + k * 1024); } while (0)
#define PG8_MMA(ai, bj, At, Bt) do { __builtin_amdgcn_s_setprio(1); _Pragma("unroll") for (int m = 0; m < 4; ++m) _Pragma("unroll") for (int n = 0; n < 2; ++n) _Pragma("unroll") for (int k = 0; k < 2; ++k) \
        acc[ai][bj][m][n] = __builtin_amdgcn_mfma_f32_16x16x32_bf16(Bt[n][k], At[m][k], acc[ai][bj][m][n], 0, 0, 0); __builtin_amdgcn_s_setprio(0); } while (0)
#define PG8_WAIT_V(n) asm volatile("s_waitcnt vmcnt(" #n ")" ::: "memory")
#define PG8_WAIT_L(n) asm volatile("s_waitcnt lgkmcnt(" #n ")" ::: "memory")
#define PG8_BAR __builtin_amdgcn_s_barrier()
#define PG8_SCHED __builtin_amdgcn_sched_barrier(0)
    Unit cur, nxt; int ui = 0;
    if (!S.next(0, cur)) return;
    f32x4 acc[2][2][4][2];
#pragma unroll
    for (int a = 0; a < 2; ++a)
#pragma unroll
        for (int b = 0; b < 2; ++b)
#pragma unroll
            for (int m = 0; m < 4; ++m)
#pragma unroll
                for (int n = 0; n < 2; ++n) acc[a][b][m][n] = (f32x4){0.f, 0.f, 0.f, 0.f};
    bf16x8 At[4][2], B0[2][2], B1[2][2];
    const char* cA = (const char*)g.A + (size_t)cur.pm * tstep; const char* cB = (const char*)g.Bt + (size_t)cur.pn * tstep;
    S.a_ready(cur);
    if constexpr (SP2) {
        PG8_STAGE(PG8_SB(0, 0), cB, voffB); PG8_STAGE(PG8_SB(0, 1), cB + hstep, voffB); PG8_STAGE(PG8_SA(0, 0), cA, voffA); PG8_STAGE(PG8_SA(0, 1), cA + hstep, voffA);
        if (wr == 1) PG8_BAR;
        PG8_WAIT_V(2); PG8_BAR;
        PG8_STAGE(PG8_SB(1, 0), cB + kstep, voffB); PG8_STAGE(PG8_SA(1, 0), cA + kstep, voffA); PG8_STAGE(PG8_SB(1, 1), cB + hstep + kstep, voffB);
        PG8_WAIT_V(6); PG8_BAR;
    } else {
        PG8_STAGE(PG8_SB(0, 0), cB, voffB); PG8_STAGE(PG8_SA(0, 0), cA, voffA); PG8_STAGE(PG8_SB(0, 1), cB + hstep, voffB); PG8_STAGE(PG8_SA(0, 1), cA + hstep, voffA);
        if (wr == 1) PG8_BAR;
        PG8_WAIT_V(4); PG8_BAR;
        PG8_STAGE(PG8_SB(1, 0), cB + kstep, voffB); PG8_STAGE(PG8_SA(1, 0), cA + kstep, voffA); PG8_STAGE(PG8_SB(1, 1), cB + hstep + kstep, voffB);
        PG8_WAIT_V(6); PG8_BAR;
    }
    for (;;) {
        const bool has_next = S.next(ui + 1, nxt);
        const char* nA = has_next ? (const char*)g.A + (size_t)nxt.pm * tstep : cA; const char* nB = has_next ? (const char*)g.Bt + (size_t)nxt.pn * tstep : cB;
        for (int t = 0; t < nt; t += 2) {
            const bool last = (t == nt - 2);
            const char* a1 = cA + (size_t)(t + 1) * kstep;
            const char* a2 = last ? nA : cA + (size_t)(t + 2) * kstep; const char* b2 = last ? nB : cB + (size_t)(t + 2) * kstep;
            const char* a3 = a2 + kstep; const char* b3 = b2 + kstep;
            if (last && has_next) S.a_ready(nxt);
            if constexpr (SP2) {
            PG8_LDB(B0, 0, 0); PG8_LDB(B1, 0, 1); PG8_SCHED; PG8_LDA(At, 0, 0); PG8_STAGE(PG8_SA(1, 1), a1 + hstep, voffA);
            PG8_WAIT_V(8); PG8_WAIT_L(0); PG8_BAR; PG8_MMA(0, 0, At, B0); PG8_MMA(0, 1, At, B1); PG8_BAR; PG8_SCHED;
            PG8_LDA(At, 0, 1); PG8_STAGE(PG8_SB(0, 0), b2, voffB); PG8_STAGE(PG8_SB(0, 1), b2 + hstep, voffB); PG8_STAGE(PG8_SA(0, 0), a2, voffA);
            PG8_WAIT_V(8); PG8_WAIT_L(0); PG8_BAR; PG8_MMA(1, 0, At, B0); PG8_MMA(1, 1, At, B1); PG8_BAR; PG8_SCHED;
            PG8_LDB(B0, 1, 0); PG8_LDB(B1, 1, 1); PG8_SCHED; PG8_LDA(At, 1, 0); PG8_STAGE(PG8_SA(0, 1), a2 + hstep, voffA);
            PG8_WAIT_V(8); PG8_WAIT_L(0); PG8_BAR; PG8_MMA(0, 0, At, B0); PG8_MMA(0, 1, At, B1); PG8_BAR; PG8_SCHED;
            PG8_LDA(At, 1, 1); PG8_STAGE(PG8_SB(1, 0), b3, voffB); PG8_STAGE(PG8_SB(1, 1), b3 + hstep, voffB); PG8_STAGE(PG8_SA(1, 0), a3, voffA);
            PG8_WAIT_V(8); PG8_WAIT_L(0); PG8_BAR; PG8_MMA(1, 0, At, B0); PG8_MMA(1, 1, At, B1); PG8_BAR; PG8_SCHED;
            } else {
            PG8_LDB(B0, 0, 0); PG8_SCHED; PG8_LDA(At, 0, 0); PG8_STAGE(PG8_SA(1, 1), a1 + hstep, voffA);
            PG8_WAIT_L(8); PG8_BAR; PG8_WAIT_L(0); PG8_MMA(0, 0, At, B0); PG8_BAR; PG8_SCHED;
            PG8_LDB(B1, 0, 1); PG8_STAGE(PG8_SB(0, 0), b2, voffB);
            PG8_BAR; PG8_WAIT_L(0); PG8_MMA(0, 1, At, B1); PG8_BAR;
            PG8_LDA(At, 0, 1); PG8_STAGE(PG8_SA(0, 0), a2, voffA);
            PG8_BAR; PG8_WAIT_L(0); PG8_MMA(1, 0, At, B0); PG8_BAR; PG8_SCHED;
            PG8_STAGE(PG8_SB(0, 1), b2 + hstep, voffB);
            PG8_WAIT_V(6); PG8_BAR; PG8_MMA(1, 1, At, B1); PG8_BAR;
            PG8_LDB(B0, 1, 0); PG8_SCHED; PG8_LDA(At, 1, 0); PG8_STAGE(PG8_SA(0, 1), a2 + hstep, voffA);
            PG8_WAIT_L(8); PG8_BAR; PG8_WAIT_L(0); PG8_MMA(0, 0, At, B0); PG8_BAR; PG8_SCHED;
            PG8_LDB(B1, 1, 1); PG8_STAGE(PG8_SB(1, 0), b3, voffB);
            PG8_BAR; PG8_WAIT_L(0); PG8_MMA(0, 1, At, B1); PG8_BAR;
            PG8_LDA(At, 1, 1); PG8_STAGE(PG8_SA(1, 0), a3, voffA);
            PG8_BAR; PG8_WAIT_L(0); PG8_MMA(1, 0, At, B0); PG8_BAR; PG8_SCHED;
            PG8_STAGE(PG8_SB(1, 1), b3 + hstep, voffB);
            PG8_WAIT_V(6); PG8_BAR; PG8_MMA(1, 1, At, B1); PG8_BAR;
            }
        }
        if constexpr (ALIGN_EPI) { if (wr == 0) PG8_BAR; }
        if constexpr (!Epi::AFTER_DRAIN) { E(acc, cur, wr, wc, fr, fq); S.done(cur); }
        if (!has_next) break;
#pragma unroll
        for (int a = 0; a < 2; ++a)
#pragma unroll
            for (int b = 0; b < 2; ++b)
#pragma unroll
                for (int m = 0; m < 4; ++m)
#pragma unroll
                    for (int n = 0; n < 2; ++n) acc[a][b][m][n] = (f32x4){0.f, 0.f, 0.f, 0.f};
        cur = nxt; cA = nA; cB = nB; ++ui;
        if constexpr (ALIGN_EPI) { if (wr == 1) PG8_BAR; }
    }
    PG8_WAIT_V(0);
    if constexpr (!ALIGN_EPI) { if (wr == 0) PG8_BAR; }
    PG8_BAR;
    if constexpr (Epi::AFTER_DRAIN) { E.fused(acc, cur, wr, wc, fr, fq, lds, wid, lane); S.done(cur); }
#undef PG8_SA
#undef PG8_SB
#undef PG8_STAGE
#undef PG8_LDA
#undef PG8_LDB
#undef PG8_MMA
#undef PG8_WAIT_V
#undef PG8_WAIT_L
#undef PG8_BAR
#undef PG8_SCHED
}
}

#ifndef PG8_SP2
#define PG8_SP2 true
#endif
#ifndef PG8_ALIGN
#define PG8_ALIGN true
#endif
#include <hip/hip_bf16.h>
#include <cmath>
namespace attn_body {
using bf16=__hip_bfloat16;
using bf16x8=__attribute__((ext_vector_type(8)))short;
using s16x4=__attribute__((ext_vector_type(4)))short;
using f32x16=__attribute__((ext_vector_type(16)))float;
using u32x4=__attribute__((ext_vector_type(4)))unsigned;
constexpr int D=64,PQ=2304,PKV=2304,PO=1024;
constexpr int NW=8,QBLK=32,QB=QBLK*NW,KVBLK=64;
__device__ __forceinline__ int crow(int r,int hi){return (r&3)+8*(r>>2)+4*hi;}
#define SBAR() __builtin_amdgcn_sched_barrier(0)
__device__ __forceinline__ void cmask(f32x16&p0,f32x16&p1,int jb,int qrel,int hi){
  const float NEG=-INFINITY; int kb=64*jb+4*hi;
  #pragma unroll
  for(int r=0;r<16;++r){int kv=kb+(r&3)+8*(r>>2); if(kv>qrel)p0[r]=NEG; if(kv+32>qrel)p1[r]=NEG;}
}

constexpr int NSLOT=3, SLOTB=8192;
constexpr int LDS_K=0, LDS_V=NSLOT*SLOTB, LDS_WS=2*NSLOT*SLOTB, LDS_OST=LDS_WS+NW*64*4, LDS_BYTES=LDS_OST+NW*4096;
constexpr float C2=0.125f*1.4426950408889634f;
__device__ __forceinline__ void glds16(const void*gsrc,unsigned lds_dst){unsigned keep;
  asm volatile("s_mov_b32 %0, m0\n\ts_mov_b32 m0, %2\n\ts_nop 0\n\tglobal_load_lds_dwordx4 %1, off\n\ts_mov_b32 m0, %0":"=&s"(keep):"v"(gsrc),"s"(lds_dst):"memory");}
__device__ __forceinline__ float max3f(float a,float b,float c){float r;asm("v_max3_f32 %0, %1, %2, %3":"=v"(r):"v"(a),"v"(b),"v"(c));return r;}
__device__ __forceinline__ float max2f(float a,float b){float r;asm("v_max_f32_e32 %0, %1, %2":"=v"(r):"v"(a),"v"(b));return r;}
__device__ __forceinline__ float fadd_s(float a,float b){float r;asm("v_add_f32_e32 %0, %1, %2":"=v"(r):"v"(a),"v"(b));return r;}
__device__ __forceinline__ float fsub_s(float a,float b){float r;asm("v_sub_f32_e32 %0, %1, %2":"=v"(r):"v"(a),"v"(b));return r;}
typedef float f32x2_t __attribute__((ext_vector_type(2))); typedef __bf16 bf16x2_t __attribute__((ext_vector_type(2)));
__device__ __forceinline__ unsigned cvtpk_s(float lo,float hi){f32x2_t v={lo,hi};bf16x2_t b=__builtin_convertvector(v,bf16x2_t);return __builtin_bit_cast(unsigned,b);}
#define WAIT_BAR(N) asm volatile("s_waitcnt vmcnt(" #N ") lgkmcnt(0)\n\ts_barrier":::"memory")

__device__ __forceinline__ void qkt(f32x16&p0,f32x16&p1,const char*Kslot,const bf16x8*qr,const f32x16&negm,int r32,int hi){
  const char*kb=Kslot+hi*1024+r32*16;
  #pragma unroll
  for(int d0=0;d0<4;++d0){
    const bf16x8 b0=*reinterpret_cast<const bf16x8*>(kb+d0*2048);
    const bf16x8 b1=*reinterpret_cast<const bf16x8*>(kb+d0*2048+512);
    if(d0==0){p0=__builtin_amdgcn_mfma_f32_32x32x16_bf16(b0,qr[0],negm,0,0,0);p1=__builtin_amdgcn_mfma_f32_32x32x16_bf16(b1,qr[0],negm,0,0,0);}
    else{p0=__builtin_amdgcn_mfma_f32_32x32x16_bf16(b0,qr[d0],p0,0,0,0);p1=__builtin_amdgcn_mfma_f32_32x32x16_bf16(b1,qr[d0],p1,0,0,0);}}
}
typedef __attribute__((address_space(3))) const char* lds_cptr;
typedef short v4i16_t __attribute__((ext_vector_type(4)));
__device__ __forceinline__ void kload8(bf16x8*kf,lds_cptr kp){
  kf[0]=*(const __attribute__((address_space(3))) bf16x8*)(kp);      kf[1]=*(const __attribute__((address_space(3))) bf16x8*)(kp+512);
  kf[2]=*(const __attribute__((address_space(3))) bf16x8*)(kp+2048); kf[3]=*(const __attribute__((address_space(3))) bf16x8*)(kp+2560);
  kf[4]=*(const __attribute__((address_space(3))) bf16x8*)(kp+4096); kf[5]=*(const __attribute__((address_space(3))) bf16x8*)(kp+4608);
  kf[6]=*(const __attribute__((address_space(3))) bf16x8*)(kp+6144); kf[7]=*(const __attribute__((address_space(3))) bf16x8*)(kp+6656);
}
__device__ __forceinline__ void kload2(bf16x8*kf,lds_cptr kp,int j){ kf[2*j]=*(const __attribute__((address_space(3))) bf16x8*)(kp+j*2048); kf[2*j+1]=*(const __attribute__((address_space(3))) bf16x8*)(kp+j*2048+512); }
__device__ __forceinline__ s16x4 vtr(lds_cptr p){ return __builtin_bit_cast(s16x4,__builtin_amdgcn_ds_read_tr16_b64_v4i16((__attribute__((address_space(3))) v4i16_t*)p)); }
__device__ __forceinline__ float rowmax(const f32x16&p0,const f32x16&p1){
  float a=max3f(p0[0],p0[1],p1[0]),b=max3f(p0[2],p0[3],p1[1]);a=max3f(a,p1[2],p1[3]);
  #pragma unroll
  for(int r=4;r<16;r+=4){a=max3f(a,p0[r],p0[r+1]);b=max3f(b,p0[r+2],p0[r+3]);a=max3f(a,p1[r],p1[r+1]);b=max3f(b,p1[r+2],p1[r+3]);}
  const float m=max2f(a,b);
  auto rr=__builtin_amdgcn_permlane32_swap(__float_as_uint(m),__float_as_uint(m),false,false);
  return max2f(__uint_as_float(rr[0]),__uint_as_float(rr[1]));
}
__device__ __forceinline__ void pv(f32x16*o,int vb,bf16x8 pa0,bf16x8 pa1,bf16x8 pa2,bf16x8 pa3){
  #pragma unroll
  for(int d0=0;d0<2;++d0){s16x4 lo[4],hi[4];
    #pragma unroll
    for(int ks=0;ks<4;++ks){
      asm volatile("ds_read_b64_tr_b16 %0,%1 offset:%c2":"=&v"(lo[ks]):"v"(vb),"i"(d0*4096+ks*1024):"memory");
      asm volatile("ds_read_b64_tr_b16 %0,%1 offset:%c2":"=&v"(hi[ks]):"v"(vb),"i"(d0*4096+ks*1024+512):"memory");}
    asm volatile("s_waitcnt lgkmcnt(0)":::"memory");SBAR();
    #define PK(k) (bf16x8){lo[k][0],lo[k][1],lo[k][2],lo[k][3],hi[k][0],hi[k][1],hi[k][2],hi[k][3]}
    o[d0]=__builtin_amdgcn_mfma_f32_32x32x16_bf16(pa0,PK(0),o[d0],0,0,0);
    o[d0]=__builtin_amdgcn_mfma_f32_32x32x16_bf16(pa1,PK(1),o[d0],0,0,0);
    o[d0]=__builtin_amdgcn_mfma_f32_32x32x16_bf16(pa2,PK(2),o[d0],0,0,0);
    o[d0]=__builtin_amdgcn_mfma_f32_32x32x16_bf16(pa3,PK(3),o[d0],0,0,0);
    #undef PK
  }
}

#ifndef ATTN_STORE16
#define ATTN_STORE16(p,v) (*(u32x4*)(p)=(v))
#endif
template<int THRL,int NT> __device__ __forceinline__ void attn_unit(int qb,const bf16*Qh,const bf16*__restrict__ Kh,const bf16*__restrict__ Vh,bf16*Oh,char*shm){
  int tid_=threadIdx.x; asm volatile("":"+v"(tid_)); const int tid=tid_,lane=tid&63,r32=lane&31,hi=lane>>5; const int wid=__builtin_amdgcn_readfirstlane(tid>>6);
  const int q0=qb*QB;
  const bf16*Qw=Qh+(long)(q0+wid*QBLK)*PQ;
  const unsigned lds0=(unsigned)(uintptr_t)shm;
  float*wsf=(float*)(shm+LDS_WS)+wid*64;
  const bf16*ksrc=Kh+(long)lane*PKV+wid*8;
  const bf16*vsrc=Vh+(long)(16*(wid&3)+(lane>>2))*PKV+(wid>>2)*32+(lane&3)*8;
  const unsigned kdst=lds0+LDS_K+wid*1024, vdst=lds0+LDS_V+wid*1024;
  #define DMA_K(t,slot) glds16(ksrc+(long)(t)*KVBLK*PKV,(unsigned)__builtin_amdgcn_readfirstlane(kdst+(slot)))
  #define DMA_V(t,slot) glds16(vsrc+(long)(t)*KVBLK*PKV,(unsigned)__builtin_amdgcn_readfirstlane(vdst+(slot)))
  const int vb0=(int)(lds0+LDS_V)+((lane>>4)&1)*32+(lane&3)*8+(4*hi+((lane&15)>>2))*64;
  const char*Kbase=shm+LDS_K; bf16x8 kf[8];
  const lds_cptr shm3=(lds_cptr)shm; const lds_cptr kp0=shm3+LDS_K+hi*1024+r32*16; const lds_cptr vp0=shm3+LDS_V+((lane>>4)&1)*32+(lane&3)*8+(4*hi+((lane&15)>>2))*64;
  DMA_K(0,0);DMA_V(0,0);DMA_K(1,SLOTB);
  bf16x8 qr[4];
  #pragma unroll
  for(int d0=0;d0<4;++d0)qr[d0]=*reinterpret_cast<const bf16x8*>(&Qw[(long)r32*PQ+d0*16+hi*8]);
  float mhat=0.f,l_reg=0.f;f32x16 o[2];o[0]=f32x16{};o[1]=f32x16{};f32x16 negm=f32x16{};asm volatile("":"+v"(negm));
  #define CMASK(P0,P1,t) do{}while(0)
  bool resc=false;
  #define START(P0,P1) do{ const float rm=rowmax(P0,P1); resc=false; \
    { const float dl=rm; mhat=fadd_s(mhat,dl); \
      _Pragma("unroll") for(int r=0;r<16;++r){P0[r]=fsub_s(P0[r],dl);P1[r]=fsub_s(P1[r],dl);} \
      _Pragma("unroll") for(int r=0;r<16;++r)negm[r]=-mhat; asm volatile("":"+v"(negm)); } \
    _Pragma("unroll") for(int r=0;r<16;++r)P0[r]=__builtin_amdgcn_exp2f(P0[r]); }while(0)
  #define RESC() do{ if(resc){ asm volatile("s_waitcnt lgkmcnt(0)":::"memory"); \
      _Pragma("unroll") for(int d_=0;d_<2;++d_) _Pragma("unroll") for(int r=0;r<16;++r)o[d_][r]*=wsf[crow(r,hi)]; } }while(0)
  f32x16 pA0,pA1,pB0,pB1;
  int sl_prev=0,sl_cur=0,sl_next=SLOTB;
  #define ROT() do{sl_prev=sl_cur;sl_cur=sl_next;sl_next=(sl_next==(NSLOT-1)*SLOTB)?0:sl_next+SLOTB;}while(0)
  DMA_K(2,2*SLOTB);
  WAIT_BAR(3);
  qkt(pA0,pA1,Kbase,qr,negm,r32,hi);asm volatile("s_nop 15\n\ts_nop 7":"+v"(pA0),"+v"(pA1));CMASK(pA0,pA1,0);
  START(pA0,pA1);
  _Pragma("unroll") for(int r=0;r<16;++r)pA1[r]=__builtin_amdgcn_exp2f(pA1[r]);
  WAIT_BAR(0);
  DMA_K(3,0);DMA_V(1,SLOTB);
  ROT();
  kload8(kf,kp0+sl_cur);
  WAIT_BAR(2);
  s16x4 vlo[8],vhi[8]; u32x4 pw0,pw1,pw2,pw3;
  #define PKW(P,B) cvtpk_s(P[B],P[B+1])
  #define PAF(k) __builtin_bit_cast(bf16x8,pw##k)
  #define VFR(i) (bf16x8){vlo[i][0],vlo[i][1],vlo[i][2],vlo[i][3],vhi[i][0],vhi[i][1],vhi[i][2],vhi[i][3]}
  #define PIN(x) asm volatile("":"+v"(x))
  #define MX3(a,b,c) __builtin_fmaxf(__builtin_fmaxf((a),(b)),(c))
  #define GAPA(MF,A0,A1,A2,A3,W0,W1,PW) do{ MF; sacc+=A0; sacc+=A1; sacc+=A2; sacc+=A3; PIN(sacc); W0; W1; PIN(PW); SBAR(); }while(0)
  #define EX(v) __builtin_amdgcn_exp2f(v)
  #define GAPB(MF,X,B) do{ MF; X[B]=EX(X[B]); X[B+1]=EX(X[B+1]); X[B+2]=EX(X[B+2]); X[B+3]=EX(X[B+3]); PIN(X); SBAR(); }while(0)
  #define VRD(i) do{ vlo[i]=vtr(vp_+(((i)>>2)*4096+((i)&3)*1024)); vhi[i]=vtr(vp_+(((i)>>2)*4096+((i)&3)*1024+512)); }while(0)
  #define KRD(G,j) do{ if(G){ kload2(kf,kp0+sl_next,j); SBAR(); } }while(0)
  #define STEP(C0,C1,P0,P1,t,GK,GV,GL) do{ SBAR(); \
    const lds_cptr vp_=vp0+sl_prev; \
    VRD(0); SBAR(); float sacc=(P0[0]+P0[1]); \
    GAPA(C0=__builtin_amdgcn_mfma_f32_32x32x16_bf16(kf[0],qr[0],negm,0,0,0), P0[2],P0[3],P0[4],P0[5],     pw0[0]=PKW(P0,0), pw0[1]=PKW(P0,2), pw0); \
    VRD(4); SBAR(); GAPA(C1=__builtin_amdgcn_mfma_f32_32x32x16_bf16(kf[1],qr[0],negm,0,0,0), P0[6],P0[7],P0[8],P0[9],     pw0[2]=PKW(P0,4), pw0[3]=PKW(P0,6), pw0); \
    VRD(1); SBAR(); GAPA(C0=__builtin_amdgcn_mfma_f32_32x32x16_bf16(kf[2],qr[1],C0,0,0,0),   P0[10],P0[11],P0[12],P0[13], pw1[0]=PKW(P0,8), pw1[1]=PKW(P0,10), pw1); \
    VRD(5); SBAR(); GAPA(C1=__builtin_amdgcn_mfma_f32_32x32x16_bf16(kf[3],qr[1],C1,0,0,0),   P0[14],P0[15],P1[0],P1[1],   pw1[2]=PKW(P0,12),pw1[3]=PKW(P0,14), pw1); \
    VRD(2); SBAR(); GAPA(C0=__builtin_amdgcn_mfma_f32_32x32x16_bf16(kf[4],qr[2],C0,0,0,0),   P1[2],P1[3],P1[4],P1[5],     pw2[0]=PKW(P1,0), pw2[1]=PKW(P1,2), pw2); \
    VRD(6); SBAR(); GAPA(C1=__builtin_amdgcn_mfma_f32_32x32x16_bf16(kf[5],qr[2],C1,0,0,0),   P1[6],P1[7],P1[8],P1[9],     pw2[2]=PKW(P1,4), pw2[3]=PKW(P1,6), pw2); \
    VRD(3); SBAR(); GAPA(C0=__builtin_amdgcn_mfma_f32_32x32x16_bf16(kf[6],qr[3],C0,0,0,0),   P1[10],P1[11],P1[12],P1[13], pw3[0]=PKW(P1,8), pw3[1]=PKW(P1,10), pw3); \
    VRD(7); SBAR(); GAPA(C1=__builtin_amdgcn_mfma_f32_32x32x16_bf16(kf[7],qr[3],C1,0,0,0),   P1[14],P1[15],0.f,0.f,       pw3[2]=PKW(P1,12),pw3[3]=PKW(P1,14), pw3); \
    l_reg+=sacc; \
    if(GK){DMA_K((t)+3,sl_cur);} if(GV){DMA_V((t)+1,sl_next);} \
    CMASK(C0,C1,t); \
    { float a=MX3(C0[0],C0[1],C1[0]),b=MX3(C0[2],C0[3],C1[1]); a=MX3(a,C1[2],C1[3]); \
      _Pragma("unroll") for(int r=4;r<16;r+=4){a=MX3(a,C0[r],C0[r+1]);b=MX3(b,C0[r+2],C0[r+3]);a=MX3(a,C1[r],C1[r+1]);b=MX3(b,C1[r+2],C1[r+3]);} \
      float rm=__builtin_fmaxf(a,b); { auto rr=__builtin_amdgcn_permlane32_swap(__float_as_uint(rm),__float_as_uint(rm),false,false); rm=__builtin_fmaxf(__uint_as_float(rr[0]),__uint_as_float(rr[1])); } \
      resc=false; \
      if(__builtin_expect(__any(rm>(float)THRL),0)){ const float dl=__builtin_fmaxf(rm,0.f); mhat+=dl; \
        _Pragma("unroll") for(int r=0;r<16;++r){C0[r]-=dl;C1[r]-=dl;} \
        _Pragma("unroll") for(int r=0;r<16;++r)negm[r]=-mhat; asm volatile("":"+v"(negm)); \
        const float f=__builtin_amdgcn_exp2f(-dl); l_reg*=f; if(hi==0)wsf[r32]=f; resc=true; } } \
    SBAR(); \
    GAPB(o[0]=__builtin_amdgcn_mfma_f32_32x32x16_bf16(PAF(0),VFR(0),o[0],0,0,0), C0,0); \
    GAPB(o[1]=__builtin_amdgcn_mfma_f32_32x32x16_bf16(PAF(0),VFR(4),o[1],0,0,0), C0,4); \
    KRD(GL,0); GAPB(o[0]=__builtin_amdgcn_mfma_f32_32x32x16_bf16(PAF(1),VFR(1),o[0],0,0,0), C0,8); \
    KRD(GL,1); GAPB(o[1]=__builtin_amdgcn_mfma_f32_32x32x16_bf16(PAF(1),VFR(5),o[1],0,0,0), C0,12); \
    KRD(GL,2); GAPB(o[0]=__builtin_amdgcn_mfma_f32_32x32x16_bf16(PAF(2),VFR(2),o[0],0,0,0), C1,0); \
    KRD(GL,3); GAPB(o[1]=__builtin_amdgcn_mfma_f32_32x32x16_bf16(PAF(2),VFR(6),o[1],0,0,0), C1,4); \
    GAPB(o[0]=__builtin_amdgcn_mfma_f32_32x32x16_bf16(PAF(3),VFR(3),o[0],0,0,0), C1,8); \
    GAPB(o[1]=__builtin_amdgcn_mfma_f32_32x32x16_bf16(PAF(3),VFR(7),o[1],0,0,0), C1,12); \
    }while(0)
  int t=1;
  #undef CMASK
  #define CMASK(P0,P1,t) do{}while(0)
  for(;t+5<NT;t+=2){
    STEP(pB0,pB1,pA0,pA1,t,true,true,true);     WAIT_BAR(2); RESC(); ROT();
    STEP(pA0,pA1,pB0,pB1,t+1,true,true,true);   WAIT_BAR(2); RESC(); ROT();
  }
  #undef CMASK
  #define CMASK(P0,P1,t) do{}while(0)
  #define ENDW(tt) do{ if((tt)+3<NT){WAIT_BAR(2);} else if((tt)+2<NT){WAIT_BAR(1);} else {WAIT_BAR(0);} }while(0)
  for(;t+1<NT;t+=2){
    STEP(pB0,pB1,pA0,pA1,t,(t+3<NT),(t+1<NT),(t+1<NT));       ENDW(t);   RESC(); ROT();
    STEP(pA0,pA1,pB0,pB1,t+1,(t+4<NT),(t+2<NT),(t+2<NT));     ENDW(t+1); RESC(); ROT();
  }
  STEP(pB0,pB1,pA0,pA1,NT-1,false,false,false); RESC();
  { float sacc=pB0[0]+pB0[1]; _Pragma("unroll") for(int r=2;r<16;++r)sacc+=pB0[r]; _Pragma("unroll") for(int r=0;r<16;++r)sacc+=pB1[r]; l_reg+=sacc;
    pw0=(u32x4){PKW(pB0,0),PKW(pB0,2),PKW(pB0,4),PKW(pB0,6)};pw1=(u32x4){PKW(pB0,8),PKW(pB0,10),PKW(pB0,12),PKW(pB0,14)};pw2=(u32x4){PKW(pB1,0),PKW(pB1,2),PKW(pB1,4),PKW(pB1,6)};pw3=(u32x4){PKW(pB1,8),PKW(pB1,10),PKW(pB1,12),PKW(pB1,14)};
    SBAR(); pv(o,vb0+sl_cur,PAF(0),PAF(1),PAF(2),PAF(3)); }
  #undef PKW
  #undef PAF
  #undef VFR
  #undef PIN
  #undef MX3
  #undef GAPA
  #undef GAPB
  #undef EX
  #undef VRD
  #undef KRD
  #undef STEP
  #undef ENDW
  {auto rr=__builtin_amdgcn_permlane32_swap(__float_as_uint(l_reg),__float_as_uint(l_reg),false,false);l_reg=__uint_as_float(rr[0])+__uint_as_float(rr[1]);}
  if(hi==0)wsf[32+r32]=l_reg;asm volatile("s_waitcnt lgkmcnt(0)":::"memory");
  float rli[16];
  #pragma unroll
  for(int r=0;r<16;++r)rli[r]=__builtin_amdgcn_rcpf(wsf[32+crow(r,hi)]);
  bf16*Ow=Oh+(long)(q0+wid*QBLK)*PO;
  { bf16*stg=(bf16*)(shm+LDS_OST)+wid*2048;
    #pragma unroll
    for(int r=0;r<16;++r){const int orow=crow(r,hi);
      #pragma unroll
      for(int d0=0;d0<2;++d0)stg[orow*64+d0*32+r32]=__float2bfloat16(o[d0][r]*rli[r]);}
    asm volatile("s_waitcnt lgkmcnt(0)":::"memory");
    #pragma unroll
    for(int i=0;i<4;++i){const int row=i*8+(lane>>3),ch=lane&7; const u32x4 v=*(const u32x4*)(stg+row*64+ch*8); ATTN_STORE16(Ow+(long)row*PO+ch*8,v);} }
  asm volatile("s_waitcnt lgkmcnt(0)\n\ts_barrier":::"memory");
  #undef DMA_K
  #undef DMA_V
  #undef CMASK
  #undef START
  #undef RESC
  #undef ROT
}
constexpr int ATTN_LDS_BYTES=LDS_BYTES;
#undef SBAR
#undef WAIT_BAR
}
namespace cg = cooperative_groups;
#define LAS __attribute__((address_space(3)))
typedef unsigned short bf16;
typedef unsigned v4u __attribute__((ext_vector_type(4)));
typedef unsigned v2u __attribute__((ext_vector_type(2)));
typedef float f32x4 __attribute__((ext_vector_type(4)));
typedef float f32x16 __attribute__((ext_vector_type(16)));
typedef short bf16x8 __attribute__((ext_vector_type(8)));
typedef short s16x4 __attribute__((ext_vector_type(4)));

constexpr int DM = 1024, MP = 16384, MS = 65536, MT = MP + MS, SP = 2048, SS = 8192;
constexpr int ABIN = 2304, CIN = 5120, DFF = 2816, DFF2 = 5632;
constexpr int NTHREADS = 512, NWAVES = 8;
constexpr int LDS_BYTES = 147456;
constexpr float ALPHA = 1.41421356237f;
constexpr float C2 = 0.125f * 1.4426950408889634f;
constexpr size_t MiB = 1u << 20;
constexpr size_t WS_W_INAB = 1 * MiB;
constexpr size_t WS_W_OUTAB = WS_W_INAB + (size_t)ABIN * DM * 2;
constexpr size_t WS_W_INC = WS_W_OUTAB + (size_t)DM * DM * 2;
constexpr size_t WS_W_OUTC = WS_W_INC + (size_t)CIN * DM * 2;
constexpr size_t WS_W_UP = WS_W_OUTC + (size_t)DM * DM * 2;
constexpr size_t WS_W_DN = WS_W_UP + 2 * (size_t)DFF2 * DM * 2;
constexpr size_t WS_W_END = WS_W_DN + 2 * (size_t)DM * DFF * 2;
constexpr size_t WS_TAB = 56 * MiB;
constexpr size_t WS_XN = 57 * MiB;
constexpr size_t WS_BIG = 217 * MiB;
constexpr size_t WS_HAB = WS_BIG;
constexpr size_t WS_YAT = WS_BIG + 360 * MiB;
constexpr size_t WS_HFF = WS_BIG;
constexpr size_t WS_HACT = WS_BIG + 440 * MiB;
constexpr size_t WS_PL = WS_BIG;
constexpr size_t PLANE = (size_t)MT * DM;
constexpr size_t WS_NEED = WS_BIG + 800 * MiB;
static_assert(WS_W_END <= WS_TAB, "weights fit");
constexpr int FCH = 40960;

struct Params {
    const float *xp, *xs, *w_in_ab, *w_out_ab, *qn, *kn, *w_in_c, *w_out_c, *lbf, *lbb, *gn, *lnmg, *lnmb, *lnfg, *lnfb, *wup, *cw, *cb, *wdn;
    float* out; unsigned char* ws;
    float fa[8]; float fb[16];
};

typedef const __attribute__((address_space(4))) Params* CP;
#define FRESH_P() ({ CP p_ = (CP)__builtin_amdgcn_kernarg_segment_ptr(); asm volatile("" : "+s"(p_)); p_; })
__device__ __forceinline__ unsigned f2bf(float f) { unsigned u = __builtin_bit_cast(unsigned, f); return (u + 0x7fffu + ((u >> 16) & 1u)) >> 16; }
__device__ __forceinline__ unsigned pk2(float lo, float hi) { return f2bf(lo) | (f2bf(hi) << 16); }
__device__ __forceinline__ float bf2f(unsigned b) { return __builtin_bit_cast(float, b << 16); }
__device__ __forceinline__ float bflo(unsigned w) { return __builtin_bit_cast(float, w << 16); }
__device__ __forceinline__ float bfhi(unsigned w) { return __builtin_bit_cast(float, w & 0xffff0000u); }
__device__ __forceinline__ float ex2(float x) { return __builtin_amdgcn_exp2f(x); }
__device__ __forceinline__ float wave_sum(float v) {
#pragma unroll
    for (int o = 1; o < 64; o <<= 1) v += __shfl_xor(v, o);
    return v;
}
#define MFMA32(a, b, c) __builtin_amdgcn_mfma_f32_32x32x16_bf16((a), (b), (c), 0, 0, 0)
__device__ __forceinline__ int crow(int r, int hi) { return (r & 3) + 8 * (r >> 2) + 4 * hi; }
__device__ __forceinline__ bf16x8 pack8(const f32x16& x, int s) {
    v4u p; p.x = pk2(x[8 * s], x[8 * s + 1]); p.y = pk2(x[8 * s + 2], x[8 * s + 3]); p.z = pk2(x[8 * s + 4], x[8 * s + 5]); p.w = pk2(x[8 * s + 6], x[8 * s + 7]);
    return __builtin_bit_cast(bf16x8, p);
}

template <int MODE> struct EpiRes {
    static constexpr bool PERM = false, AFTER_DRAIN = false;
    const float* b0; const float* b1; int split_row; const bf16* bx; float* out;
    __device__ __forceinline__ void operator()(const pg8::f32x4 (&acc)[2][2][4][2], const pg8::Unit& u, int wr, int wc, int fr, int fq) const {
        const int col0 = u.pn * 256 + wc * 32 + 4 * fq;
#pragma unroll
        for (int ai = 0; ai < 2; ++ai)
#pragma unroll
            for (int m = 0; m < 4; ++m) {
                const int row = u.pm * 256 + ai * 128 + wr * 64 + m * 16 + fr;
                float* op = out + (size_t)row * DM + col0;
                if (MODE == 0) {
                    const float* bp = (row < split_row ? b0 + (size_t)row * DM : b1 + (size_t)(row - split_row) * DM) + col0;
#pragma unroll
                    for (int bj = 0; bj < 2; ++bj)
#pragma unroll
                        for (int n = 0; n < 2; ++n) { const f32x4 bs = *(const f32x4*)(bp + bj * 128 + n * 16); *(f32x4*)(op + bj * 128 + n * 16) = bs * ALPHA + acc[ai][bj][m][n]; }
                } else {
                    const bf16* bp = bx + (size_t)row * DM + col0;
#pragma unroll
                    for (int bj = 0; bj < 2; ++bj)
#pragma unroll
                        for (int n = 0; n < 2; ++n) { const v2u w = *(const v2u*)(bp + bj * 128 + n * 16); f32x4 bs = {bflo(w.x), bfhi(w.x), bflo(w.y), bfhi(w.y)}; *(f32x4*)(op + bj * 128 + n * 16) = bs * ALPHA + acc[ai][bj][m][n]; }
                }
            }
    }
};

__device__ __forceinline__ void p0_transpose_item(const float* W, int K, int N, bf16* WT, LAS float* scr, int item, int lane) {
    const int nblk = N / 32, kb = item / nblk, nb = item % nblk, k0 = 64 * kb, n0 = 32 * nb;
#pragma unroll 8
    for (int i = 0; i < 32; ++i) { const int kk = 2 * i + (lane >> 5); scr[kk * 33 + (lane & 31)] = W[(size_t)(k0 + kk) * N + n0 + (lane & 31)]; }
    asm volatile("s_waitcnt lgkmcnt(0)" ::: "memory");
    const int c = lane & 7;
#pragma unroll
    for (int j = 0; j < 4; ++j) { const int n = (lane >> 3) + 8 * j; const LAS float* s = scr + (8 * c) * 33 + n;
        v4u o; o.x = pk2(s[0 * 33], s[1 * 33]); o.y = pk2(s[2 * 33], s[3 * 33]); o.z = pk2(s[4 * 33], s[5 * 33]); o.w = pk2(s[6 * 33], s[7 * 33]);
        *(v4u*)(WT + (size_t)(n0 + n) * K + k0 + 8 * c) = o; }
    asm volatile("s_waitcnt lgkmcnt(0)" ::: "memory");
}
__device__ __forceinline__ void sincos_rev(int pos, float f, float& c, float& s) {
    const float p = (float)pos, hi = p * f, lo = __builtin_fmaf(p, f, -hi);
    const float fr = (hi - __builtin_floorf(hi)) + lo;
    c = __builtin_amdgcn_cosf(fr); s = __builtin_amdgcn_sinf(fr);
}
__device__ __forceinline__ void phase_prologue(CP P, LAS unsigned char* lds, int gw, int NGW, int lane, int wave) {
    unsigned char* ws = P->ws;
    LAS float* scr = (LAS float*)(lds + wave * 16384);
    constexpr int I0 = 16 * (ABIN / 32), I1 = 16 * 32, I2 = 16 * (CIN / 32), I3 = 16 * 32, I4 = 16 * (DFF2 / 32), I6 = (DFF / 64) * 32;
    constexpr int NIT = I0 + I1 + I2 + I3 + 2 * I4 + 2 * I6;
    for (int it = gw; it < NIT; it += NGW) {
        int r = it;
        if (r < I0) { p0_transpose_item(P->w_in_ab, DM, ABIN, (bf16*)(ws + WS_W_INAB), scr, r, lane); continue; } r -= I0;
        if (r < I1) { p0_transpose_item(P->w_out_ab, DM, DM, (bf16*)(ws + WS_W_OUTAB), scr, r, lane); continue; } r -= I1;
        if (r < I2) { p0_transpose_item(P->w_in_c, DM, CIN, (bf16*)(ws + WS_W_INC), scr, r, lane); continue; } r -= I2;
        if (r < I3) { p0_transpose_item(P->w_out_c, DM, DM, (bf16*)(ws + WS_W_OUTC), scr, r, lane); continue; } r -= I3;
        if (r < 2 * I4) { const int l = r / I4; p0_transpose_item(P->wup + (size_t)l * DM * DFF2, DM, DFF2, (bf16*)(ws + WS_W_UP) + (size_t)l * DFF2 * DM, scr, r % I4, lane); continue; } r -= 2 * I4;
        { const int l = r / I6; p0_transpose_item(P->wdn + (size_t)l * DFF * DM, DFF, DM, (bf16*)(ws + WS_W_DN) + (size_t)l * DM * DFF, scr, r % I6, lane); }
    }
    bf16* XN = (bf16*)(ws + WS_XN);
    for (int m = gw; m < MT; m += NGW) {
        const float* xr = (m < MP) ? P->xp + (size_t)m * DM : P->xs + (size_t)(m - MP) * DM;
        const f32x4* x4 = (const f32x4*)xr + lane; v2u* o = (v2u*)(XN + (size_t)m * DM) + lane;
#pragma unroll
        for (int j = 0; j < 4; ++j) { const f32x4 v = x4[64 * j]; v2u w; w.x = pk2(v.x, v.y); w.y = pk2(v.z, v.w); o[64 * j] = w; }
    }
    float2* TA = (float2*)(ws + WS_TAB); float2* TR = TA + 8192 * 8; float2* TC = TR + 128 * 16;
    const int gt = gw * 64 + lane, NT_ = NGW * 64;
    for (int i = gt; i < 8192 * 8; i += NT_) { float c, s; sincos_rev(i >> 3, P->fa[i & 7], c, s); TA[i] = make_float2(c, s); }
    for (int i = gt; i < 128 * 16; i += NT_) { float c, s; sincos_rev(i >> 4, P->fb[i & 15], c, s); TR[i] = make_float2(c, s); }
    for (int i = gt; i < 64 * 16; i += NT_) { float c, s; sincos_rev(i >> 4, P->fb[i & 15], c, s); TC[i] = make_float2(c, s); }
}

__device__ __forceinline__ void phase_prep(CP P, int gw, int NGW, int lane) {
    unsigned char* ws = P->ws; bf16* H = (bf16*)(ws + WS_HAB);
    const float2* TA = (const float2*)(ws + WS_TAB); const float2* TR = TA + 8192 * 8; const float2* TC = TR + 128 * 16;
    const int slot = lane >> 3, j = lane & 7;
    for (int item = gw; item < MT * 4; item += NGW) {
        const int m = item >> 2, sg = item & 3;
        const int t = (m < MP) ? (m & (SP - 1)) : ((m - MP) & (SS - 1));
        bool active = true; int col;
        if (sg == 0) col = 64 * slot; else if (sg == 1) col = 512 + 64 * slot; else if (sg == 2) col = 1536 + 64 * slot;
        else { active = slot < 2; col = 2048 + 64 * (slot & 1); }
        bf16* p = H + (size_t)m * ABIN + col + 8 * j;
        const v4u raw = *(const v4u*)p;
        float x[8] = {bflo(raw.x), bfhi(raw.x), bflo(raw.y), bfhi(raw.y), bflo(raw.z), bfhi(raw.z), bflo(raw.w), bfhi(raw.w)};
        float o[8];
        if (sg < 2) {
            active = j < 2;
#pragma unroll
            for (int e = 0; e < 8; ++e) { const float y = __shfl_xor(x[e], 1); const float2 cs = TA[t * 8 + e]; o[e] = (j & 1) ? x[e] * cs.x + y * cs.y : x[e] * cs.x - y * cs.y; }
        } else {
            float ss = 0.f;
#pragma unroll
            for (int e = 0; e < 8; ++e) ss += x[e] * x[e];
            ss += __shfl_xor(ss, 1); ss += __shfl_xor(ss, 2); ss += __shfl_xor(ss, 4);
            const float r = 1.0f / sqrtf(ss * (1.0f / 64.0f) + 1e-6f);
            const float* gain = (sg == 2 ? P->qn : P->kn) + 8 * j;
            const int pos = (j < 4) ? (t >> 6) : (t & 63); const float2* T = (j < 4 ? TR : TC) + pos * 16 + 8 * (j & 1);
            const float sc = (sg == 2) ? C2 : 1.0f;
#pragma unroll
            for (int e = 0; e < 8; ++e) x[e] = x[e] * r * gain[e];
#pragma unroll
            for (int e = 0; e < 8; ++e) { const float y = __shfl_xor(x[e], 2); const float2 cs = T[e]; o[e] = ((j & 2) ? x[e] * cs.x + y * cs.y : x[e] * cs.x - y * cs.y) * sc; }
        }
        if (active) { v4u w; w.x = pk2(o[0], o[1]); w.y = pk2(o[2], o[3]); w.z = pk2(o[4], o[5]); w.w = pk2(o[6], o[7]); *(v4u*)p = w; }
    }
}

__device__ __forceinline__ void dilated_unit(const bf16* H, bf16* Y, int R0, int S, int h, int sp, LAS unsigned char* lds, int tid, int wave, int lane) {
    LAS float* ACC = (LAS float*)lds;
    LAS float* MX = ACC + 512 * 65;
    LAS float* LX = MX + 512;
    LAS float* WSM = LX + 512 + wave * 64;
    const int r32 = lane & 31, hi = lane >> 5;
#pragma unroll 1
    for (int g = 0; g < 3; ++g) {
        const int dil = (g == 0) ? 1 : (g == 1 ? 4 : 16), m = S / dil;
#pragma unroll 1
        for (int tk = wave; tk < 16; tk += 8) {
            const int c = tk % dil, blk = tk / dil, i0 = (512 / dil) * sp + 32 * blk;
            const bf16* Qp = H + (size_t)(R0 + c + dil * (i0 + r32)) * ABIN + 64 * h + 8 * hi;
            bf16x8 qf[4];
#pragma unroll
            for (int d0 = 0; d0 < 4; ++d0) qf[d0] = *(const bf16x8*)(Qp + 16 * d0);
            f32x16 st[5];
#pragma unroll
            for (int jt = 0; jt < 5; ++jt) {
                int ik = i0 - 64 + 32 * jt + r32; ik = ik < 0 ? 0 : (ik >= m ? m - 1 : ik);
                const bf16* Kp = H + (size_t)(R0 + c + dil * ik) * ABIN + 512 + 64 * h + 8 * hi;
                bf16x8 kf[4];
#pragma unroll
                for (int d0 = 0; d0 < 4; ++d0) kf[d0] = *(const bf16x8*)(Kp + 16 * d0);
                f32x16 a = {};
#pragma unroll
                for (int d0 = 0; d0 < 4; ++d0) a = MFMA32(kf[d0], qf[d0], a);
                st[jt] = a;
            }
            float mx = -INFINITY;
#pragma unroll
            for (int jt = 0; jt < 5; ++jt)
#pragma unroll
                for (int r = 0; r < 16; ++r) {
                    const int kq = -64 + 32 * jt + crow(r, hi), rel = kq - r32, ikr = i0 + kq;
                    const bool ok = (rel <= 64) && (rel >= -64) && (ikr >= 0) && (ikr < m);
                    const float s = ok ? st[jt][r] * C2 : -INFINITY; st[jt][r] = s; mx = fmaxf(mx, s);
                }
            mx = fmaxf(mx, __shfl_xor(mx, 32));
            float l = 0.f;
#pragma unroll
            for (int jt = 0; jt < 5; ++jt)
#pragma unroll
                for (int r = 0; r < 16; ++r) { const float p = ex2(st[jt][r] - mx); st[jt][r] = p; l += p; }
            l += __shfl_xor(l, 32);
            f32x16 o0 = {}, o1 = {};
#pragma unroll
            for (int jt = 0; jt < 5; ++jt)
#pragma unroll
                for (int s = 0; s < 2; ++s) {
                    const bf16x8 pa = pack8(st[jt], s);
                    bf16x8 v0, v1;
#pragma unroll
                    for (int jj = 0; jj < 8; ++jj) {
                        int ik = i0 - 64 + 32 * jt + 16 * s + 8 * (jj >> 2) + 4 * hi + (jj & 3); ik = ik < 0 ? 0 : (ik >= m ? m - 1 : ik);
                        const bf16* Vp = H + (size_t)(R0 + c + dil * ik) * ABIN + 1024 + 64 * h + r32;
                        v0[jj] = (short)Vp[0]; v1[jj] = (short)Vp[32];
                    }
                    o0 = MFMA32(pa, v0, o0); o1 = MFMA32(pa, v1, o1);
                }
            if (hi == 0) { WSM[r32] = mx; WSM[32 + r32] = l; }
            asm volatile("s_waitcnt lgkmcnt(0)" ::: "memory");
#pragma unroll
            for (int r = 0; r < 16; ++r) {
                const int q = crow(r, hi); const float mt = WSM[q], lt = WSM[32 + q];
                const int tl = c + dil * (i0 + q) - 512 * sp;
                LAS float* ap = ACC + tl * 65 + r32;
                if (g == 0) { ap[0] = o0[r]; ap[32] = o1[r]; if (r32 == 0) { MX[tl] = mt; LX[tl] = lt; } }
                else {
                    const float mo = MX[tl], lo = LX[tl], mn = fmaxf(mo, mt), so = ex2(mo - mn), sn = ex2(mt - mn);
                    ap[0] = ap[0] * so + o0[r] * sn; ap[32] = ap[32] * so + o1[r] * sn;
                    asm volatile("s_waitcnt lgkmcnt(0)" ::: "memory");
                    if (r32 == 0) { MX[tl] = mn; LX[tl] = lo * so + lt * sn; }
                }
            }
            asm volatile("s_waitcnt lgkmcnt(0)" ::: "memory");
        }
        __syncthreads();
    }
    {
        const float inv = 1.0f / LX[tid]; const LAS float* ap = ACC + tid * 65;
        bf16* yp = Y + (size_t)(R0 + 512 * sp + tid) * DM + 64 * h;
#pragma unroll
        for (int c8 = 0; c8 < 8; ++c8) { v4u w; w.x = pk2(ap[8 * c8] * inv, ap[8 * c8 + 1] * inv); w.y = pk2(ap[8 * c8 + 2] * inv, ap[8 * c8 + 3] * inv);
            w.z = pk2(ap[8 * c8 + 4] * inv, ap[8 * c8 + 5] * inv); w.w = pk2(ap[8 * c8 + 6] * inv, ap[8 * c8 + 7] * inv); *(v4u*)(yp + 8 * c8) = w; }
    }
    __syncthreads();
}

__device__ __forceinline__ void phase_ln(float* X, bf16* XN, const float* g, const float* b, int gw, int NGW, int lane) {
    f32x4 gv[4], bv[4];
#pragma unroll
    for (int j = 0; j < 4; ++j) { gv[j] = ((const f32x4*)g)[lane + 64 * j]; bv[j] = ((const f32x4*)b)[lane + 64 * j]; }
    for (int m = gw; m < MT; m += NGW) {
        f32x4* xr = (f32x4*)(X + (size_t)m * DM) + lane;
        f32x4 v[4]; float s = 0.f;
#pragma unroll
        for (int j = 0; j < 4; ++j) { v[j] = xr[64 * j]; s += (v[j].x + v[j].y) + (v[j].z + v[j].w); }
        const float mean = wave_sum(s) * (1.f / DM); float s2 = 0.f;
#pragma unroll
        for (int j = 0; j < 4; ++j) { v[j] = v[j] - mean; s2 += (v[j].x * v[j].x + v[j].y * v[j].y) + (v[j].z * v[j].z + v[j].w * v[j].w); }
        const float rstd = 1.f / sqrtf(wave_sum(s2) * (1.f / DM) + 1e-5f);
        v2u* o = (v2u*)(XN + (size_t)m * DM) + lane;
#pragma unroll
        for (int j = 0; j < 4; ++j) { const f32x4 y = v[j] * rstd * gv[j] + bv[j]; xr[64 * j] = y; v2u w; w.x = pk2(y.x, y.y); w.y = pk2(y.z, y.w); o[64 * j] = w; }
    }
}

__device__ __forceinline__ float gelu_tanh(float v) {
    const float y = 0.7978845608f * (v + 0.044715f * v * v * v);
    const float e = ex2(y * 2.885390082f);
    const float th = 1.0f - 2.0f / (e + 1.0f);
    return 0.5f * v * (1.0f + th);
}
__device__ __forceinline__ void phase_conv(CP P, int layer, int r0, int gtid, int nthr) {
    const bf16* HF = (const bf16*)(P->ws + WS_HFF); bf16* HA = (bf16*)(P->ws + WS_HACT);
    const float* cw = P->cw + (size_t)layer * 3 * DFF; const float* cb = P->cb + (size_t)layer * DFF;
    constexpr int NCG = DFF / 8, NTB = FCH / 16;
    for (int it = gtid; it < NCG * NTB; it += nthr) {
        const int cgp = it % NCG, tb = it / NCG, c0 = 8 * cgp;
        const int ml = 16 * tb, m = r0 + ml;
        const int t0 = (m < MP) ? (m & (SP - 1)) : ((m - MP) & (SS - 1)); const int S = (m < MP) ? SP : SS;
        float w0[8], w1[8], w2[8], bb[8];
#pragma unroll
        for (int e = 0; e < 8; ++e) { w0[e] = cw[c0 + e]; w1[e] = cw[DFF + c0 + e]; w2[e] = cw[2 * DFF + c0 + e]; bb[e] = cb[c0 + e]; }
        const bf16* gp = HF + (size_t)ml * DFF2 + DFF + c0; const bf16* up = HF + (size_t)ml * DFF2 + c0; bf16* op = HA + (size_t)ml * DFF + c0;
        v4u prev = {0u, 0u, 0u, 0u}, cur, nxt;
        if (t0 > 0) prev = *(const v4u*)(gp - DFF2);
        cur = *(const v4u*)gp;
#pragma unroll 4
        for (int i = 0; i < 16; ++i) {
            if (t0 + i + 1 < S) nxt = *(const v4u*)(gp + (size_t)(i + 1) * DFF2); else nxt = (v4u){0u, 0u, 0u, 0u};
            const v4u uu = *(const v4u*)(up + (size_t)i * DFF2);
            const unsigned pw[4] = {prev.x, prev.y, prev.z, prev.w}, cwv[4] = {cur.x, cur.y, cur.z, cur.w}, nw[4] = {nxt.x, nxt.y, nxt.z, nxt.w}, uw[4] = {uu.x, uu.y, uu.z, uu.w};
            unsigned ow[4];
#pragma unroll
            for (int e2 = 0; e2 < 4; ++e2) {
                const float a0 = bflo(pw[e2]) * w0[2 * e2] + bflo(cwv[e2]) * w1[2 * e2] + bflo(nw[e2]) * w2[2 * e2] + bb[2 * e2];
                const float a1 = bfhi(pw[e2]) * w0[2 * e2 + 1] + bfhi(cwv[e2]) * w1[2 * e2 + 1] + bfhi(nw[e2]) * w2[2 * e2 + 1] + bb[2 * e2 + 1];
                ow[e2] = pk2(gelu_tanh(a0) * bflo(uw[e2]), gelu_tanh(a1) * bfhi(uw[e2]));
            }
            *(v4u*)(op + (size_t)i * DFF) = (v4u){ow[0], ow[1], ow[2], ow[3]};
            prev = cur; cur = nxt;
        }
    }
}
__device__ __forceinline__ float dpp_scan64(float v) {
    int x;
    x = __builtin_amdgcn_update_dpp(0, __builtin_bit_cast(int, v), 0x111, 0xf, 0xf, false); v += __builtin_bit_cast(float, x);
    x = __builtin_amdgcn_update_dpp(0, __builtin_bit_cast(int, v), 0x112, 0xf, 0xf, false); v += __builtin_bit_cast(float, x);
    x = __builtin_amdgcn_update_dpp(0, __builtin_bit_cast(int, v), 0x114, 0xf, 0xf, false); v += __builtin_bit_cast(float, x);
    x = __builtin_amdgcn_update_dpp(0, __builtin_bit_cast(int, v), 0x118, 0xf, 0xf, false); v += __builtin_bit_cast(float, x);
    x = __builtin_amdgcn_update_dpp(0, __builtin_bit_cast(int, v), 0x142, 0xa, 0xf, false); v += __builtin_bit_cast(float, x);
    x = __builtin_amdgcn_update_dpp(0, __builtin_bit_cast(int, v), 0x143, 0xc, 0xf, false); v += __builtin_bit_cast(float, x);
    return v;
}
typedef short v4i16_t __attribute__((ext_vector_type(4)));
__device__ __forceinline__ bf16x8 tr8(const LAS bf16* p0, const LAS bf16* p1) {
    const s16x4 lo = __builtin_bit_cast(s16x4, __builtin_amdgcn_ds_read_tr16_b64_v4i16((LAS v4i16_t*)p0));
    const s16x4 hi = __builtin_bit_cast(s16x4, __builtin_amdgcn_ds_read_tr16_b64_v4i16((LAS v4i16_t*)p1));
    return __builtin_shufflevector(lo, hi, 0, 1, 2, 3, 4, 5, 6, 7);
}
__device__ __forceinline__ void scan_unit(CP P, int R0, int S, int h, int dir, int vh, LAS unsigned char* lds, int tid, int wave, int lane) {
    const bf16* PQ = (const bf16*)(P->ws + WS_PL); const bf16* PZ = PQ + (size_t)(1 + dir) * PLANE; const bf16* PI = PQ + 3 * PLANE;
    bf16* OUT = (bf16*)P->out + (size_t)dir * PLANE;
    constexpr int QP = 136, VP = 72;
    LAS bf16* QT = (LAS bf16*)lds;
    LAS bf16* KK = QT + 64 * QP;
    LAS bf16* KH = KK + 64 * QP;
    LAS bf16* VV = KH + 64 * QP;
    LAS float* OB = (LAS float*)(VV + 64 * VP);
    LAS float* DEC = OB + 4 * 64 * 64;
    const int r32 = lane & 31, hi = lane >> 5;
    const int kb = wave >> 1, vb = wave & 1;
    const int g1 = (lane >> 4) & 1, qq = (lane & 15) >> 2, pp = lane & 3;
    const float* lbt = dir ? P->lbb : P->lbf;
    float oml[16];
#pragma unroll
    for (int e = 0; e < 16; ++e) { const float t0_ = lbt[128 * h + 16 * wave + e], t1_ = lbt[1024 + 128 * h + 16 * wave + e]; oml[e] = 1.0f - __builtin_amdgcn_rcpf(1.0f + __expf(t0_ - t1_)); }
    const int nc = S / 64;
    f32x16 St = {};
    const size_t colq = (size_t)128 * h + 16 * wave;
    const int vs = tid >> 3, vc = tid & 7;
    const size_t colv = (size_t)128 * h + 64 * vh + 8 * vc;
#define SCAN_ROW(c, tau) (R0 + (dir ? (S - 1 - (64 * (c) + (tau))) : (64 * (c) + (tau))))
    v4u rq0, rq1, rz0, rz1, ri;
    { const size_t ro = (size_t)SCAN_ROW(0, lane) * DM + colq; rq0 = *(const v4u*)(PQ + ro); rq1 = *(const v4u*)(PQ + ro + 8); rz0 = *(const v4u*)(PZ + ro); rz1 = *(const v4u*)(PZ + ro + 8);
      ri = *(const v4u*)(PI + (size_t)SCAN_ROW(0, vs) * DM + colv); }
#pragma unroll 1
    for (int c = 0; c < nc; ++c) {
        {
            const unsigned qw[8] = {rq0.x, rq0.y, rq0.z, rq0.w, rq1.x, rq1.y, rq1.z, rq1.w}, zw[8] = {rz0.x, rz0.y, rz0.z, rz0.w, rz1.x, rz1.y, rz1.z, rz1.w};
            unsigned oq[8], ok[8], oh[8]; float dtot[16];
#pragma unroll
            for (int e2 = 0; e2 < 8; ++e2) {
                float res[2][3];
#pragma unroll
                for (int u = 0; u < 2; ++u) {
                    const int e = 2 * e2 + u;
                    const float z = u ? bfhi(zw[e2]) : bflo(zw[e2]), q = u ? bfhi(qw[e2]) : bflo(qw[e2]);
                    const float kg = oml[e] * __builtin_amdgcn_rcpf(1.0f + __expf(z));
                    const float lf2 = __log2f(1.0f - kg);
                    const float b = dpp_scan64(lf2);
                    const float tot = __builtin_bit_cast(float, __builtin_amdgcn_readlane(__builtin_bit_cast(int, b), 63));
                    dtot[e] = tot;
                    res[u][0] = q * ex2(b); res[u][1] = kg * ex2(-b); res[u][2] = kg * ex2(tot - b);
                }
                oq[e2] = pk2(res[0][0], res[1][0]); ok[e2] = pk2(res[0][1], res[1][1]); oh[e2] = pk2(res[0][2], res[1][2]);
            }
            LAS bf16* qd = QT + lane * QP + 16 * wave; LAS bf16* kd = KK + lane * QP + 16 * wave; LAS bf16* hd = KH + lane * QP + 16 * wave;
            *(LAS v4u*)qd = (v4u){oq[0], oq[1], oq[2], oq[3]}; *(LAS v4u*)(qd + 8) = (v4u){oq[4], oq[5], oq[6], oq[7]};
            *(LAS v4u*)kd = (v4u){ok[0], ok[1], ok[2], ok[3]}; *(LAS v4u*)(kd + 8) = (v4u){ok[4], ok[5], ok[6], ok[7]};
            *(LAS v4u*)hd = (v4u){oh[0], oh[1], oh[2], oh[3]}; *(LAS v4u*)(hd + 8) = (v4u){oh[4], oh[5], oh[6], oh[7]};
            if (lane < 16) { float d = dtot[0];
#pragma unroll
                for (int e = 1; e < 16; ++e) d = (lane == e) ? dtot[e] : d;
                DEC[16 * wave + lane] = ex2(d); }
            const unsigned iw[4] = {ri.x, ri.y, ri.z, ri.w}; unsigned ov[4];
#pragma unroll
            for (int e2 = 0; e2 < 4; ++e2) { const float a = bflo(iw[e2]), b = bfhi(iw[e2]); ov[e2] = pk2(a * __builtin_amdgcn_rcpf(1.0f + __expf(-a)), b * __builtin_amdgcn_rcpf(1.0f + __expf(-b))); }
            *(LAS v4u*)(VV + vs * VP + 8 * vc) = (v4u){ov[0], ov[1], ov[2], ov[3]};
        }
        if (c + 1 < nc) { const size_t ro = (size_t)SCAN_ROW(c + 1, lane) * DM + colq; rq0 = *(const v4u*)(PQ + ro); rq1 = *(const v4u*)(PQ + ro + 8); rz0 = *(const v4u*)(PZ + ro); rz1 = *(const v4u*)(PZ + ro + 8);
            ri = *(const v4u*)(PI + (size_t)SCAN_ROW(c + 1, vs) * DM + colv); }
        __syncthreads();
        {
            f32x16 op0 = {}, op1 = {};
#pragma unroll
            for (int s = 0; s < 2; ++s) {
                const bf16x8 sf = pack8(St, s);
                const int kof = 32 * kb + 16 * s + 4 * hi;
                const s16x4 a0l = *(const LAS s16x4*)(QT + r32 * QP + kof), a0h = *(const LAS s16x4*)(QT + r32 * QP + kof + 8);
                const s16x4 a1l = *(const LAS s16x4*)(QT + (32 + r32) * QP + kof), a1h = *(const LAS s16x4*)(QT + (32 + r32) * QP + kof + 8);
                op0 = MFMA32(__builtin_shufflevector(a0l, a0h, 0, 1, 2, 3, 4, 5, 6, 7), sf, op0);
                op1 = MFMA32(__builtin_shufflevector(a1l, a1h, 0, 1, 2, 3, 4, 5, 6, 7), sf, op1);
            }
            const int tbi = kb & 1, sbi = kb >> 1;
            if (sbi <= tbi) {
                f32x16 pt = {};
#pragma unroll
                for (int kk = 0; kk < 8; ++kk) {
                    const bf16x8 a = *(const LAS bf16x8*)(KK + (32 * sbi + r32) * QP + 16 * kk + 8 * hi);
                    const bf16x8 b = *(const LAS bf16x8*)(QT + (32 * tbi + r32) * QP + 16 * kk + 8 * hi);
                    pt = MFMA32(a, b, pt);
                }
                if (sbi == tbi) {
#pragma unroll
                    for (int r = 0; r < 16; ++r) if (crow(r, hi) > r32) pt[r] = 0.f;
                }
                f32x16 oi = {};
#pragma unroll
                for (int s = 0; s < 2; ++s) {
                    const bf16x8 pa = pack8(pt, s);
                    const LAS bf16* vp = VV + (32 * sbi + 16 * s + 4 * hi + qq) * VP + 32 * vb + 16 * g1 + 4 * pp;
                    oi = MFMA32(pa, tr8(vp, vp + 8 * VP), oi);
                }
                if (tbi == 0) op0 += oi; else op1 += oi;
            }
#pragma unroll
            for (int r = 0; r < 16; ++r) {
                const int t = crow(r, hi);
                OB[kb * 4096 + t * 64 + 32 * vb + r32] = op0[r];
                OB[kb * 4096 + (32 + t) * 64 + 32 * vb + r32] = op1[r];
            }
#pragma unroll
            for (int r = 0; r < 16; ++r) St[r] *= DEC[32 * kb + crow(r, hi)];
#pragma unroll
            for (int s = 0; s < 4; ++s) {
                const LAS bf16* ap = KH + (16 * s + 8 * hi + qq) * QP + 32 * kb + 16 * g1 + 4 * pp;
                const LAS bf16* bp = VV + (16 * s + 8 * hi + qq) * VP + 32 * vb + 16 * g1 + 4 * pp;
                St = MFMA32(tr8(ap, ap + 4 * QP), tr8(bp, bp + 4 * VP), St);
            }
        }
        __syncthreads();
        {
            const int t = tid >> 3, v0 = 8 * (tid & 7);
            f32x4 a = *(const LAS f32x4*)(OB + t * 64 + v0), b = *(const LAS f32x4*)(OB + t * 64 + v0 + 4);
#pragma unroll
            for (int p_ = 1; p_ < 4; ++p_) { a += *(const LAS f32x4*)(OB + p_ * 4096 + t * 64 + v0); b += *(const LAS f32x4*)(OB + p_ * 4096 + t * 64 + v0 + 4); }
            v4u w; w.x = pk2(a.x, a.y); w.y = pk2(a.z, a.w); w.z = pk2(b.x, b.y); w.w = pk2(b.z, b.w);
            *(v4u*)(OUT + (size_t)SCAN_ROW(c, t) * DM + 128 * h + 64 * vh + v0) = w;
        }
    }
#undef SCAN_ROW
    __syncthreads();
}

__device__ __forceinline__ void phase_combine(CP P, int gw, int NGW, int lane) {
    const bf16* OF = (const bf16*)P->out; const bf16* OBW = OF + PLANE;
    bf16* PQ = (bf16*)(P->ws + WS_PL); const bf16* PG = PQ + 4 * PLANE;
    float gnv[16];
#pragma unroll
    for (int e = 0; e < 16; ++e) gnv[e] = P->gn[16 * lane + e];
    for (int m = gw; m < MT; m += NGW) {
        const size_t off = (size_t)m * DM + 16 * lane;
        const v4u f0 = *(const v4u*)(OF + off), f1 = *(const v4u*)(OF + off + 8), b0 = *(const v4u*)(OBW + off), b1 = *(const v4u*)(OBW + off + 8);
        const v4u g0 = *(const v4u*)(PG + off), g1 = *(const v4u*)(PG + off + 8);
        const unsigned fw[8] = {f0.x, f0.y, f0.z, f0.w, f1.x, f1.y, f1.z, f1.w}, bw[8] = {b0.x, b0.y, b0.z, b0.w, b1.x, b1.y, b1.z, b1.w}, gw_[8] = {g0.x, g0.y, g0.z, g0.w, g1.x, g1.y, g1.z, g1.w};
        float o[16]; float ss = 0.f;
#pragma unroll
        for (int e = 0; e < 8; ++e) { o[2 * e] = bflo(fw[e]) + bflo(bw[e]); o[2 * e + 1] = bfhi(fw[e]) + bfhi(bw[e]); ss += o[2 * e] * o[2 * e] + o[2 * e + 1] * o[2 * e + 1]; }
        ss += __shfl_xor(ss, 1); ss += __shfl_xor(ss, 2); ss += __shfl_xor(ss, 4);
        const float r = 1.0f / sqrtf(ss * (1.0f / 128.0f) + 1e-6f);
        unsigned ow[8];
#pragma unroll
        for (int e = 0; e < 8; ++e) {
            const float ga = bflo(gw_[e]), gb = bfhi(gw_[e]);
            const float ya = o[2 * e] * r * gnv[2 * e] * (ga / (1.0f + __expf(-ga))), yb = o[2 * e + 1] * r * gnv[2 * e + 1] * (gb / (1.0f + __expf(-gb)));
            ow[e] = pk2(ya, yb);
        }
        *(v4u*)(PQ + off) = (v4u){ow[0], ow[1], ow[2], ow[3]}; *(v4u*)(PQ + off + 8) = (v4u){ow[4], ow[5], ow[6], ow[7]};
    }
}

#ifndef PHM
#define PHM 0xffff
#endif
#ifndef REP_SCAN
#define REP_SCAN 1
#endif
#ifndef REP_DIL
#define REP_DIL 1
#endif
#define IDS() CP P = FRESH_P(); int tid = threadIdx.x; asm volatile("" : "+v"(tid)); const int lane = tid & 63, wave = __builtin_amdgcn_readfirstlane(tid >> 6); \
    int bid = blockIdx.x; asm volatile("" : "+s"(bid)); const int G = gridDim.x; const int vcu = (G % 8 == 0) ? (bid % 8) * (G / 8) + bid / 8 : bid; \
    const int gw = vcu * NWAVES + wave, NGW = G * NWAVES; const int gtid = bid * NTHREADS + tid, nthr = G * NTHREADS; unsigned char* ws = P->ws; bf16* XN = (bf16*)(ws + WS_XN); \
    (void)lane; (void)gw; (void)NGW; (void)gtid; (void)nthr; (void)XN; (void)vcu;
__global__ void __launch_bounds__(NTHREADS, 2) fwd_megakernel(Params Pin) {
    extern __shared__ __attribute__((aligned(16))) unsigned char lds_raw[];
    LAS unsigned char* lds = (LAS unsigned char*)lds_raw;
    cg::grid_group grid = cg::this_grid();
    typedef pg8::EpiBf16<0> EB;

    if (PHM & 1) { IDS(); phase_prologue(P, lds, gw, NGW, lane, wave); }
    grid.sync();
#pragma unroll 1
    for (int layer = 0; layer < 2; ++layer) {
        if (layer == 0) {
            if (PHM & 2) { IDS(); pg8::Gemm g{XN, (const bf16*)(ws + WS_W_INAB), MT, ABIN, DM}; pg8::StaticOrder S; S.init(MT, ABIN, G, bid);
              EB E{(bf16*)(ws + WS_HAB), ABIN, nullptr, 0, 0, 1.f};
              pg8::gemm_phase<EB, pg8::StaticOrder, PG8_ALIGN, PG8_SP2>(lds, g, S, E); }
            grid.sync();
            if (PHM & 4) { IDS(); phase_prep(P, gw, NGW, lane); }
            grid.sync();
            if (PHM & 8) { IDS();
                const bf16* H = (const bf16*)(ws + WS_HAB); bf16* Y = (bf16*)(ws + WS_YAT);
                for (int U = vcu; U < 2048; U += G) {
                    const int x = (U & 255) >> 5, j = U & 31, i = U >> 8, u = i * 32 + j, grp = u >> 7, rem = u & 127, h = grp * 4 + (rem >> 5), qb = rem & 31;
                    const size_t rb = (size_t)MP + (size_t)x * SS;
                    attn_body::attn_unit<8, SS / 64>(qb, (const attn_body::bf16*)(H + rb * ABIN + 1536 + 64 * h), (const attn_body::bf16*)(H + rb * ABIN + 2048 + 64 * grp),
                                            (const attn_body::bf16*)(H + rb * ABIN + 2176 + 64 * grp), (attn_body::bf16*)(Y + rb * DM + 512 + 64 * h), (char*)lds_raw);
                }
            }
            if (PHM & 8) { IDS();
                const bf16* H = (const bf16*)(ws + WS_HAB); bf16* Y = (bf16*)(ws + WS_YAT);
                for (int U = vcu; U < 512; U += G) {
                    const int x = (U & 255) >> 5, j = U & 31, i = U >> 8, u = i * 32 + j, h = u >> 3, qb = u & 7, grp = h >> 2;
                    const size_t rb = (size_t)x * SP;
                    attn_body::attn_unit<8, SP / 64>(qb, (const attn_body::bf16*)(H + rb * ABIN + 1536 + 64 * h), (const attn_body::bf16*)(H + rb * ABIN + 2048 + 64 * grp),
                                            (const attn_body::bf16*)(H + rb * ABIN + 2176 + 64 * grp), (attn_body::bf16*)(Y + rb * DM + 512 + 64 * h), (char*)lds_raw);
                }
            }
            __syncthreads();
            for (int rep_ = 0; rep_ < REP_DIL; ++rep_) if (PHM & 16) { IDS();
                const bf16* H = (const bf16*)(ws + WS_HAB); bf16* Y = (bf16*)(ws + WS_YAT);
                for (int U = vcu; U < 1024; U += G) {
                    const int x = (U & 255) >> 5, j = U & 31, i = U >> 8, u = i * 32 + j, h = u >> 4, sp = u & 15;
                    dilated_unit(H, Y, MP + x * SS, SS, h, sp, lds, tid, wave, lane);
                }
                for (int U = vcu; U < 256; U += G) {
                    const int x = (U & 255) >> 5, j = U & 31, h = j >> 2, sp = j & 3;
                    dilated_unit(H, Y, x * SP, SP, h, sp, lds, tid, wave, lane);
                }
            }
            grid.sync();
            if (PHM & 32) { IDS(); pg8::Gemm g{(const bf16*)(ws + WS_YAT), (const bf16*)(ws + WS_W_OUTAB), MT, DM, DM}; pg8::StaticOrder S; S.init(MT, DM, G, bid);
              EpiRes<0> E{P->xp, P->xs, MP, nullptr, P->out};
              pg8::gemm_phase<EpiRes<0>, pg8::StaticOrder, PG8_ALIGN, PG8_SP2>(lds, g, S, E); }
            grid.sync();
        } else {
            if (PHM & 64) { IDS(); pg8::Gemm g{XN, (const bf16*)(ws + WS_W_INC), MT, CIN, DM}; pg8::StaticOrder S; S.init(MT, CIN, G, bid);
              EB E{(bf16*)(ws + WS_PL), DM, nullptr, DM, PLANE, 1.f};
              pg8::gemm_phase<EB, pg8::StaticOrder, PG8_ALIGN, PG8_SP2>(lds, g, S, E); }
            grid.sync();
            for (int rep_ = 0; rep_ < REP_SCAN; ++rep_) if (PHM & 128) { IDS();
              for (int U = vcu; U < 512; U += G) {
                const int lng = U < 256, u = U & 255, x = u >> 5, rem = u & 31, h = rem >> 2, dir = (rem >> 1) & 1, vh = rem & 1;
                scan_unit(P, lng ? MP + x * SS : x * SP, lng ? SS : SP, h, dir, vh, lds, tid, wave, lane);
              } }
            grid.sync();
            if (PHM & 256) { IDS(); phase_combine(P, gw, NGW, lane); }
            grid.sync();
            if (PHM & 512) { IDS(); pg8::Gemm g{(const bf16*)(ws + WS_PL), (const bf16*)(ws + WS_W_OUTC), MT, DM, DM}; pg8::StaticOrder S; S.init(MT, DM, G, bid);
              EpiRes<1> E{nullptr, nullptr, 0, XN, P->out};
              pg8::gemm_phase<EpiRes<1>, pg8::StaticOrder, PG8_ALIGN, PG8_SP2>(lds, g, S, E); }
            grid.sync();
        }
        if (PHM & 1024) { IDS(); phase_ln(P->out, XN, P->lnmg + layer * DM, P->lnmb + layer * DM, gw, NGW, lane); }
        grid.sync();
#pragma unroll 1
        for (int ch = 0; ch < 2; ++ch) {
            const int r0 = ch * FCH;
            if (PHM & 2048) { IDS(); pg8::Gemm g{XN + (size_t)r0 * DM, (const bf16*)(ws + WS_W_UP) + (size_t)layer * DFF2 * DM, FCH, DFF2, DM}; pg8::StaticOrder S; S.init(FCH, DFF2, G, bid);
              EB E{(bf16*)(ws + WS_HFF), DFF2, nullptr, 0, 0, 1.f};
              pg8::gemm_phase<EB, pg8::StaticOrder, PG8_ALIGN, PG8_SP2>(lds, g, S, E); }
            grid.sync();
            if (PHM & 4096) { IDS(); phase_conv(P, layer, r0, gtid, nthr); }
            grid.sync();
            if (PHM & 8192) { IDS(); pg8::Gemm g{(const bf16*)(ws + WS_HACT), (const bf16*)(ws + WS_W_DN) + (size_t)layer * DM * DFF, FCH, DM, DFF}; pg8::StaticOrder S; S.init(FCH, DM, G, bid);
              float* o = P->out + (size_t)r0 * DM;
              EpiRes<0> E{o, o, 1 << 30, nullptr, o};
              pg8::gemm_phase<EpiRes<0>, pg8::StaticOrder, PG8_ALIGN, PG8_SP2>(lds, g, S, E); }
            grid.sync();
        }
        if (PHM & 16384) { IDS(); phase_ln(P->out, XN, P->lnfg + layer * DM, P->lnfb + layer * DM, gw, NGW, lane); }
        if (layer == 0) grid.sync();
    }
}

extern "C" void kernel_launch(void* const* d_in, const int* in_sizes, int n_in, void* d_out, int out_size, void* d_ws, size_t ws_size, hipStream_t stream) {
    static int grid = 0;
    if (grid == 0) {
        if (n_in != 19 || out_size != MT * DM || ws_size < WS_NEED) { fprintf(stderr, "kernel_launch: unexpected shapes: n_in %d out %d ws %zu (need %zu)\n", n_in, out_size, ws_size, (size_t)WS_NEED); grid = -1; return; }
        int dev = 0, cus = 0, per_cu = 0;
        hipGetDevice(&dev); hipDeviceGetAttribute(&cus, hipDeviceAttributeMultiprocessorCount, dev);
        if (hipFuncSetAttribute((const void*)fwd_megakernel, hipFuncAttributeMaxDynamicSharedMemorySize, LDS_BYTES) != hipSuccess) { fprintf(stderr, "kernel_launch: hipFuncSetAttribute failed\n"); grid = -1; return; }
        if (hipOccupancyMaxActiveBlocksPerMultiprocessor(&per_cu, (const void*)fwd_megakernel, NTHREADS, LDS_BYTES) != hipSuccess || per_cu < 1) { fprintf(stderr, "kernel_launch: occupancy query gives %d\n", per_cu); per_cu = 1; }
        (void)hipGetLastError();
        grid = cus * 1;
    }
    if (grid < 0) return;
    Params p{};
    const float** pp = (const float**)&p;
    for (int i = 0; i < 19; ++i) pp[i] = (const float*)d_in[i];
    p.out = (float*)d_out; p.ws = (unsigned char*)d_ws;
    for (int i = 0; i < 8; ++i) p.fa[i] = (float)(pow(500000.0, -(double)i / 8.0) / 6.283185307179586476925);
    for (int i = 0; i < 16; ++i) p.fb[i] = (float)(pow(10000.0, -(double)i / 16.0) / 6.283185307179586476925);
    void* args[] = {&p};
    hipError_t e = hipLaunchCooperativeKernel((const void*)fwd_megakernel, dim3(grid), dim3(NTHREADS), args, LDS_BYTES, stream);
    if (e != hipSuccess) fprintf(stderr, "cooperative launch failed: %s (grid %d)\n", hipGetErrorString(e), grid);
}
```
